# Optimizing an MI355X kernel written in HIP

```python
import jax, jax.numpy as jnp
from jax import lax
import numpy as np

D_MODEL = 1024
BATCH = 16
SEQ = 256
DEPTH = 4
DEC_BATCH = 4
DEC_SEQ = 2048
PAST_LEN = 256

GRID_W = 64
N_HEADS = 8
N_KV_HEADS = 2
HEAD_DIM = 64
GQA_GROUP = N_HEADS // N_KV_HEADS
ATTN_WIDTH = N_HEADS * HEAD_DIM
KV_WIDTH = N_KV_HEADS * HEAD_DIM
POOL_WIDTH = D_MODEL - ATTN_WIDTH
POOL_WINDOWS = (2, 4, 8, 16)
N_POOL_GROUPS = len(POOL_WINDOWS)
POOL_GROUP_W = POOL_WIDTH // N_POOL_GROUPS
IN_WIDTH = ATTN_WIDTH + 2 * KV_WIDTH + ATTN_WIDTH + 2 * POOL_WIDTH
WINDOW = 128
BLOCK = 128
SPAN = BLOCK + 2 * WINDOW
AXIS_DIM = HEAD_DIM // 2
ROPE_THETA = 10000.0
EPS = 1e-6
NEG_INF = -1e30

kernel_name = "hybrid_dit_swa_pool_step"


def _rmsnorm(x, w):
    xf = x.astype(jnp.float32)
    r = lax.rsqrt(jnp.mean(xf * xf, axis=-1, keepdims=True) + EPS)
    return (xf * r).astype(x.dtype) * w


def _rope_2d(x, rows):
    row = jnp.repeat(jnp.arange(rows), GRID_W).astype(jnp.float32)
    col = jnp.tile(jnp.arange(GRID_W), rows).astype(jnp.float32)
    inv = ROPE_THETA ** (-(jnp.arange(0, AXIS_DIM, 2, dtype=jnp.float32) / AXIS_DIM))

    def rot(xa, pos):
        ang = pos[:, None] * inv[None, :]
        cos = jnp.cos(ang)[None, :, None, :].astype(xa.dtype)
        sin = jnp.sin(ang)[None, :, None, :].astype(xa.dtype)
        x1, x2 = xa[..., : AXIS_DIM // 2], xa[..., AXIS_DIM // 2:]
        return jnp.concatenate([x1 * cos - x2 * sin, x2 * cos + x1 * sin], axis=-1)

    return jnp.concatenate([rot(x[..., :AXIS_DIM], row), rot(x[..., AXIS_DIM:], col)], axis=-1)


def _attend(qb, k, v, mask, sink):
    s = jnp.einsum("bqkgd,bnkd->bkgqn", qb, k).astype(jnp.float32) * (HEAD_DIM ** -0.5)
    if mask is not None:
        s = jnp.where(mask[None, None, None], s, NEG_INF)
    sk = sink.astype(jnp.float32)[None, :, :, None, None]
    m = jnp.maximum(jnp.max(s, axis=-1, keepdims=True), sk)
    e = jnp.exp(s - m)
    p = e / (jnp.sum(e, axis=-1, keepdims=True) + jnp.exp(sk - m))
    return jnp.einsum("bkgqn,bnkd->bqkgd", p.astype(v.dtype), v)


def _context_attention(q, k, v, sink):
    B, L = q.shape[0], q.shape[1]
    nb = L // BLOCK
    qs = jnp.moveaxis(q.reshape(B, nb, BLOCK, N_KV_HEADS, GQA_GROUP, HEAD_DIM), 1, 0)
    sk = sink.reshape(N_KV_HEADS, GQA_GROUP)
    out = lax.map(lambda qb: _attend(qb, k, v, None, sk), qs)
    return jnp.moveaxis(out, 0, 1).reshape(B, L, ATTN_WIDTH)


def _latent_attention(q, k, v, kc, vc, sink):
    B, L = q.shape[0], q.shape[1]
    Lc = kc.shape[1]
    nb = L // BLOCK
    pad = ((0, 0), (WINDOW, WINDOW), (0, 0), (0, 0))
    kp, vp = jnp.pad(k, pad), jnp.pad(v, pad)
    qs = jnp.moveaxis(q.reshape(B, nb, BLOCK, N_KV_HEADS, GQA_GROUP, HEAD_DIM), 1, 0)
    sk = sink.reshape(N_KV_HEADS, GQA_GROUP)
    qi = jnp.arange(BLOCK)[:, None]
    rj = jnp.arange(SPAN)[None, :]
    ctx_mask = jnp.ones((BLOCK, Lc), dtype=bool)

    def one(args):
        b, qb = args
        start = b * BLOCK
        kb = lax.dynamic_slice_in_dim(kp, start, SPAN, axis=1)
        vb = lax.dynamic_slice_in_dim(vp, start, SPAN, axis=1)
        qpos = start + qi
        kpos = start - WINDOW + rj
        band = (jnp.abs(qpos - kpos) <= WINDOW) & (kpos >= 0) & (kpos < L)
        mask = jnp.concatenate([band, ctx_mask], axis=1)
        return _attend(qb, jnp.concatenate([kb, kc], axis=1),
                       jnp.concatenate([vb, vc], axis=1), mask, sk)

    out = lax.map(one, (jnp.arange(nb), qs))
    return jnp.moveaxis(out, 0, 1).reshape(B, L, ATTN_WIDTH)


def _pool_mixer(u, w_pool, pool_scale):
    B, L = u.shape[0], u.shape[1]
    t = jnp.arange(L)
    ug = u.reshape(B, L, N_POOL_GROUPS, POOL_GROUP_W)
    outs = []
    for g, w in enumerate(POOL_WINDOWS):
        xg = ug[:, :, g].astype(jnp.float32)
        cs = jnp.concatenate([jnp.zeros((B, 1, POOL_GROUP_W), jnp.float32),
                              lax.cumsum(xg, axis=1)], axis=1)
        lo = jnp.clip(t - w // 2, 0, L)
        hi = jnp.clip(t + w // 2, 0, L)
        mean = (cs[:, hi] - cs[:, lo]) / (hi - lo).astype(jnp.float32)[None, :, None]
        outs.append(mean - xg)
    pooled = jnp.stack(outs, axis=2).astype(u.dtype)
    y = jnp.einsum("blgc,gcd->blgd", pooled, w_pool).reshape(B, L, POOL_WIDTH)
    return y * pool_scale


def _modulated_projection(x, mod, norm_w, w_in):
    shift, scale, gate = jnp.split(mod, 3, axis=-1)
    h = _rmsnorm(x, norm_w) * (1.0 + scale) + shift
    p = h @ w_in
    o1 = ATTN_WIDTH
    o2 = o1 + KV_WIDTH
    o3 = o2 + KV_WIDTH
    o4 = o3 + ATTN_WIDTH
    o5 = o4 + POOL_WIDTH
    q, k, v, ga, u, gp = jnp.split(p, [o1, o2, o3, o4, o5], axis=-1)
    B, L = x.shape[0], x.shape[1]
    q = q.reshape(B, L, N_HEADS, HEAD_DIM)
    k = k.reshape(B, L, N_KV_HEADS, HEAD_DIM)
    v = v.reshape(B, L, N_KV_HEADS, HEAD_DIM)
    return q, k, v, ga, u, gp, gate


def _merge_output(x, attn_out, ga, pool_out, gp, gate, attn_norm, pool_norm, w_out):
    a = _rmsnorm(attn_out, attn_norm) * jax.nn.silu(ga)
    pl = _rmsnorm(pool_out, pool_norm) * jax.nn.silu(gp)
    y = jnp.concatenate([a, pl], axis=-1) @ w_out
    return x + gate * y


def setup_inputs(seed: int = 0) -> dict:
    key = jax.random.key(seed)
    ks = jax.random.split(key, 20)
    f32 = jnp.float32
    D = D_MODEL
    cache_shape = (DEC_BATCH, DEPTH, PAST_LEN, N_KV_HEADS, HEAD_DIM)
    return {
        "x_prompt": jax.random.normal(ks[0], (BATCH, SEQ, D), f32),
        "x_sample": jax.random.normal(ks[1], (DEC_BATCH, DEC_SEQ, D), f32),
        "cache_k": jax.random.normal(ks[2], cache_shape, f32),
        "cache_v": jax.random.normal(ks[3], cache_shape, f32),
        "c": jax.random.normal(ks[4], (DEC_BATCH, D), f32),
        "c_ctx": jax.random.normal(ks[5], (D,), f32),
        "norm_w": 1.0 + 0.02 * jax.random.normal(ks[6], (DEPTH, D), f32),
        "w_ada": 0.5 * D ** -0.5 * jax.random.normal(ks[7], (DEPTH, D, 3 * D), f32),
        "b_ada": 0.02 * jax.random.normal(ks[8], (DEPTH, 3 * D), f32),
        "w_in": D ** -0.5 * jax.random.normal(ks[9], (DEPTH, D, IN_WIDTH), f32),
        "sink": 0.5 * jax.random.normal(ks[10], (DEPTH, N_HEADS), f32),
        "attn_norm": 1.0 + 0.02 * jax.random.normal(ks[11], (DEPTH, ATTN_WIDTH), f32),
        "pool_norm": 1.0 + 0.02 * jax.random.normal(ks[12], (DEPTH, POOL_WIDTH), f32),
        "w_pool": POOL_GROUP_W ** -0.5 * jax.random.normal(
            ks[13], (DEPTH, N_POOL_GROUPS, POOL_GROUP_W, POOL_GROUP_W), f32),
        "pool_scale": 1.0 + 0.1 * jax.random.normal(ks[14], (DEPTH, POOL_WIDTH), f32),
        "w_out": D ** -0.5 * jax.random.normal(ks[15], (DEPTH, D, D), f32),
        "final_norm": 1.0 + 0.02 * jax.random.normal(ks[16], (D,), f32),
    }


def reference(x_prompt, x_sample, cache_k, cache_v, c, c_ctx, norm_w, w_ada, b_ada,
              w_in, sink, attn_norm, pool_norm, w_pool, pool_scale, w_out, final_norm):
    silu_ctx = jax.nn.silu(c_ctx)
    silu_c = jax.nn.silu(c)
    xp, xs = x_prompt, x_sample
    rows = xs.shape[1] // GRID_W
    new_k, new_v = [], []
    for l in range(DEPTH):
        mod_ctx = (silu_ctx @ w_ada[l] + b_ada[l])[None, None, :]
        mod_lat = (silu_c @ w_ada[l] + b_ada[l])[:, None, :]

        q, k, v, ga, u, gp, gate = _modulated_projection(xp, mod_ctx, norm_w[l], w_in[l])
        attn = _context_attention(q, k, v, sink[l])
        pool = _pool_mixer(u, w_pool[l], pool_scale[l])
        xp = _merge_output(xp, attn, ga, pool, gp, gate, attn_norm[l], pool_norm[l], w_out[l])
        new_k.append(k)
        new_v.append(v)

        q, k, v, ga, u, gp, gate = _modulated_projection(xs, mod_lat, norm_w[l], w_in[l])
        q = _rope_2d(q, rows)
        k = _rope_2d(k, rows)
        attn = _latent_attention(q, k, v, cache_k[:, l], cache_v[:, l], sink[l])
        pool = _pool_mixer(u, w_pool[l], pool_scale[l])
        xs = _merge_output(xs, attn, ga, pool, gp, gate, attn_norm[l], pool_norm[l], w_out[l])

    y_prompt = _rmsnorm(xp, final_norm)
    y_sample = _rmsnorm(xs, final_norm)
    k_state = jnp.stack(new_k, axis=1)
    v_state = jnp.stack(new_v, axis=1)
    return (y_prompt, y_sample, k_state, v_state)
```

```cpp
#include <hip/hip_runtime.h>
#include <hip/hip_cooperative_groups.h>
#include <cstdio>
namespace cg = cooperative_groups;

typedef __attribute__((ext_vector_type(8))) short bf16x8;
typedef __attribute__((ext_vector_type(4))) short s16x4;
typedef __attribute__((ext_vector_type(16))) float f32x16;
typedef __attribute__((ext_vector_type(4))) float f32x4;
typedef __bf16 bf2_t __attribute__((ext_vector_type(2)));
typedef float f2_t __attribute__((ext_vector_type(2)));
typedef unsigned short ushort_t;

#define DI __device__ __forceinline__
#define MFMA32(a, b, c) __builtin_amdgcn_mfma_f32_32x32x16_bf16((a), (b), (c), 0, 0, 0)

constexpr int NTOK = 12288, NCTX = 4096, DM = 1024, INW = 2304;
constexpr float EPS = 1e-6f;
constexpr float LOG2E = 1.4426950408889634f;

constexpr size_t OFF_WTIN = 0;
constexpr size_t OFF_WTOUT = OFF_WTIN + 4ull * 2304 * 1024 * 2;
constexpr size_t OFF_WTPOOL = OFF_WTOUT + 4ull * 1024 * 1024 * 2;
constexpr size_t OFF_MODPART = OFF_WTPOOL + 4ull * 4 * 128 * 128 * 2;
constexpr size_t OFF_MOD = OFF_MODPART + 16ull * 4 * 5 * 3072 * 4;
constexpr size_t OFF_SWPART = OFF_MOD + 4ull * 5 * 3072 * 4;
constexpr size_t OFF_SW = OFF_SWPART + 16ull * 4 * 5 * 2304 * 4;
constexpr size_t OFF_ROPE = OFF_SW + 4ull * 5 * 2304 * 4;
constexpr size_t OFF_X = OFF_ROPE + 64 * 16 * 8;
constexpr size_t OFF_XG = OFF_X + 12288ull * 1024 * 4;
constexpr size_t OFF_P = OFF_XG + 12288ull * 1024 * 2;
constexpr size_t OFF_AM = OFF_P + 12288ull * 2304 * 2;
constexpr size_t OFF_ROWSS = OFF_AM + 12288ull * 1024 * 2;
constexpr size_t OFF_SSA = OFF_ROWSS + 12288ull * 16 * 4;
constexpr size_t OFF_SSP = OFF_SSA + 12288ull * 8 * 4;
constexpr size_t OFF_BAR = OFF_SSP + 12288ull * 8 * 4;
constexpr size_t OFF_X1 = OFF_BAR + 16384;

constexpr int SMEM_BYTES = 131072;
constexpr int L_RATIO = SMEM_BYTES;
constexpr int L_RP = L_RATIO + 1024;
constexpr int L_GG = L_RP + 1024;
constexpr int L_SW = L_GG + 2048;
constexpr int L_RR = L_SW + 1024;
constexpr int L_ROPE = L_RR + 1024;
constexpr int L_XB = L_ROPE + 8192;
constexpr int SMEM_TOTAL = L_XB + 16;

struct Params {
  const float *x_prompt, *x_sample, *cache_k, *cache_v, *c, *c_ctx, *norm_w, *w_ada, *b_ada, *w_in, *sink, *attn_norm,
      *pool_norm, *w_pool, *pool_scale, *w_out, *final_norm;
  float* out;
  unsigned char* ws;
};

DI unsigned pack2(float a, float b) {
  f2_t v = {a, b};
  return __builtin_bit_cast(unsigned, __builtin_convertvector(v, bf2_t));
}
DI float bflo(unsigned u) { return __uint_as_float(u << 16); }
DI float bfhi(unsigned u) { return __uint_as_float(u & 0xffff0000u); }
DI float silu_f(float x) { return x / (1.f + __expf(-x)); }
DI int opq(int x) { asm volatile("" : "+v"(x)); return x; }
DI int lane_id_v() {
  int r;
  asm volatile("v_mbcnt_lo_u32_b32 %0, -1, 0\n\tv_mbcnt_hi_u32_b32 %0, -1, %0" : "=v"(r));
  return r;
}
#define TIDX (wave_s * 64 + lane_id_v())
DI size_t opq_o(size_t o) { asm volatile("" : "+s"(o)); return o; }
DI int crow(int i, int h) { return (i & 3) + 8 * (i >> 2) + 4 * h; }


#define XB_TMO      128
#define XB_XCNT(j)  (256  + 64 * (j))
#define XB_XSUB(j)  (1280 + 64 * (j))
#define XB_XGEN(j)  (2304 + 64 * (j))
#define XB_TOP      3328
#define XB_TOPGEN   3392
#define XCD_BAR_WORDS 3456
#define XB_SPIN_CAP (1u << 18)
#define LAS __attribute__((address_space(3)))
DI unsigned xb_ld(unsigned* p) { return __hip_atomic_load(p, __ATOMIC_RELAXED, __HIP_MEMORY_SCOPE_AGENT); }
DI unsigned xb_add(unsigned* p, unsigned v) { return __hip_atomic_fetch_add(p, v, __ATOMIC_RELAXED, __HIP_MEMORY_SCOPE_AGENT); }
DI unsigned xb_xcc_id() { return (unsigned)__builtin_amdgcn_s_getreg((3 << 11) | 20) & 0xFu; }
#define XB_SPIN(cond, bar) do { unsigned _sp = 0; while (cond) { __builtin_amdgcn_s_sleep(1); \
    if ((++_sp & 255u) == 0u) { if (xb_ld(&(bar)[XB_TMO])) break; if (_sp > XB_SPIN_CAP) { atomicAdd(&(bar)[XB_TMO], 1u); break; } } } } while (0)
struct XcdBarrier { unsigned* bar; unsigned x; volatile LAS unsigned* st; };
DI XcdBarrier xcd_barrier_post(unsigned* bar, volatile LAS unsigned* st, bool is_t0) {
  XcdBarrier b; b.bar = bar; b.x = xb_xcc_id(); b.st = st;
  if (is_t0) (void)xb_add(&bar[XB_XCNT(b.x)], 1u);
  return b;
}
DI void xcd_barrier_complete(unsigned* bar, unsigned x, unsigned& nloc, unsigned& nx) {
  const unsigned G = gridDim.x * gridDim.y * gridDim.z;
  unsigned sum, cnt, mine, sp = 0u;
  for (;;) {
    sum = 0u; cnt = 0u; mine = 0u;
#pragma unroll
    for (unsigned j = 0; j < 16; ++j) { const unsigned c = xb_ld(&bar[XB_XCNT(j)]); sum += c; cnt += (c > 0u) ? 1u : 0u; mine = (j == x) ? c : mine; }
    if (sum == G) break;
    __builtin_amdgcn_s_sleep(1);
    if ((++sp & 255u) == 0u) { if (xb_ld(&bar[XB_TMO])) break; if (sp > XB_SPIN_CAP) { atomicAdd(&bar[XB_TMO], 1u); break; } }
  }
  nloc = mine > 0u ? mine : 1u; nx = cnt > 0u ? cnt : 1u;
}
DI void xcd_barrier(const XcdBarrier& b, bool is_t0) {
  asm volatile("s_waitcnt vmcnt(0)" ::: "memory");
  __syncthreads();
  if (is_t0) {
    unsigned* bar = b.bar;
    __builtin_amdgcn_s_waitcnt(0);
    unsigned nloc = b.st[0], nx = b.st[1];
    if (nloc == 0u) { xcd_barrier_complete(bar, b.x, nloc, nx); b.st[0] = nloc; b.st[1] = nx; }
    const unsigned old = xb_add(&bar[XB_XSUB(b.x)], 1u);
    const unsigned gen = old / nloc;
    if (old + 1u == (gen + 1u) * nloc) {
      __builtin_amdgcn_fence(__ATOMIC_RELEASE, "agent");
      asm volatile("s_waitcnt vmcnt(0)" ::: "memory");
      const unsigned og = xb_add(&bar[XB_TOP], 1u);
      const unsigned tg = og / nx;
      if (og + 1u == (tg + 1u) * nx) xb_add(&bar[XB_TOPGEN], 1u);
      else XB_SPIN(xb_ld(&bar[XB_TOPGEN]) == tg, bar);
      __builtin_amdgcn_fence(__ATOMIC_ACQUIRE, "agent");
      xb_add(&bar[XB_XGEN(b.x)], 1u);
      asm volatile("s_waitcnt vmcnt(0)" ::: "memory");
    } else {
      XB_SPIN(xb_ld(&bar[XB_XGEN(b.x)]) == gen, bar);
      __builtin_amdgcn_fence(__ATOMIC_ACQUIRE, "agent");
      asm volatile("s_waitcnt vmcnt(0)" ::: "memory");
    }
  }
  __syncthreads();
}


constexpr int G_HT = 128 * 64;
DI int lds_byte(int r, int c) {
  int st = (r >> 4) * 2 + (c >> 5), rr = r & 15, cc = c & 31, ob = rr * 64 + cc * 2;
  return st * 1024 + (ob ^ (((ob >> 9) & 1) << 5));
}
DI void stage_rc(int b, int& R, int& C) {
  int st = b / 1024, sb = b % 1024, swz = sb ^ (((sb >> 9) & 1) << 5);
  R = (st >> 1) * 16 + swz / 64;
  C = (st & 1) * 32 + (swz % 64) / 2;
}

template <class Mid>
DI void gemm256(const ushort_t* __restrict__ A, const ushort_t* __restrict__ Bt, f32x4 (&acc)[2][2][4][2],
                unsigned char* shm_, Mid mid, const int wave_s) {
  constexpr int K = 1024, BK = 64, HALF = 128, nt = K / BK;
  ushort_t* shm = (ushort_t*)shm_;
  const int tid = TIDX;
  const int wid = tid >> 6, lane = tid & 63, wr = wid >> 2, wc = wid & 3, fr = lane & 15, fq = lane >> 4;
  unsigned go0, go1;
  {
    int r_, c_;
    stage_rc(tid * 16, r_, c_);
    go0 = (unsigned)(r_ * K + c_) * 2u;
    stage_rc(tid * 16 + 8192, r_, c_);
    go1 = (unsigned)(r_ * K + c_) * 2u;
  }
#define SA(b, h) (shm + ((b) * 2 + (h)) * G_HT)
#define SB(b, h) (shm + (4 + (b) * 2 + (h)) * G_HT)
#define STAGE(P, BASE, br, kt)                                                                                      \
  do {                                                                                                              \
    const char* _g = (const char*)((BASE) + (size_t)(br) * K + (kt) * BK);                                          \
    __builtin_amdgcn_global_load_lds((const unsigned*)(_g + go0), (LAS unsigned*)((char*)(P) + wave_s * 1024), 16, 0, 0); \
    __builtin_amdgcn_global_load_lds((const unsigned*)(_g + go1), (LAS unsigned*)((char*)(P) + wave_s * 1024 + 8192), 16, 0, 0); \
  } while (0)
#define LDA(dst, b, h)                                                                                              \
  _Pragma("unroll") for (int m = 0; m < 4; ++m) _Pragma("unroll") for (int k = 0; k < 2; ++k)                       \
      dst[m][k] = *reinterpret_cast<const bf16x8*>((char*)SA(b, h) + lds_byte(wr * 64 + m * 16 + fr, k * 32 + fq * 8))
#define LDB(dst, b, h)                                                                                              \
  _Pragma("unroll") for (int n = 0; n < 2; ++n) _Pragma("unroll") for (int k = 0; k < 2; ++k)                       \
      dst[n][k] = *reinterpret_cast<const bf16x8*>((char*)SB(b, h) + lds_byte(wc * 32 + n * 16 + fr, k * 32 + fq * 8))
#define MMA(ai, bj, At_, Bt_)                                                                                       \
  do {                                                                                                              \
    __builtin_amdgcn_s_setprio(1);                                                                                  \
    _Pragma("unroll") for (int m = 0; m < 4; ++m) _Pragma("unroll") for (int n = 0; n < 2; ++n)                     \
        _Pragma("unroll") for (int k = 0; k < 2; ++k) acc[ai][bj][m][n] =                                           \
            __builtin_amdgcn_mfma_f32_16x16x32_bf16(At_[m][k], Bt_[n][k], acc[ai][bj][m][n], 0, 0, 0);              \
    __builtin_amdgcn_s_setprio(0);                                                                                  \
  } while (0)
#define WAIT_V(n) asm volatile("s_waitcnt vmcnt(" #n ")" ::: "memory")
#define WAIT_L(n) asm volatile("s_waitcnt lgkmcnt(" #n ")" ::: "memory")
#define BAR __builtin_amdgcn_s_barrier()
#define SCHED __builtin_amdgcn_sched_barrier(0)
  bf16x8 At[4][2], B0[2][2], B1[2][2];
  STAGE(SB(0, 0), Bt, 0, 0); STAGE(SA(0, 0), A, 0, 0);
  STAGE(SB(0, 1), Bt, HALF, 0); STAGE(SA(0, 1), A, HALF, 0);
  if (wr == 1) BAR;
  WAIT_V(4); BAR;
  STAGE(SB(1, 0), Bt, 0, 1); STAGE(SA(1, 0), A, 0, 1); STAGE(SB(1, 1), Bt, HALF, 1);
  WAIT_V(6); BAR;
#pragma unroll 1
  for (int t = 0; t < nt - 2; t += 2) {
    if (t == nt / 2) mid(acc);
    LDB(B0, 0, 0); SCHED; LDA(At, 0, 0); STAGE(SA(1, 1), A, HALF, t + 1);
    WAIT_L(8); BAR; WAIT_L(0); MMA(0, 0, At, B0); BAR; SCHED;
    LDB(B1, 0, 1); STAGE(SB(0, 0), Bt, 0, t + 2);
    BAR; WAIT_L(0); MMA(0, 1, At, B1); BAR;
    LDA(At, 0, 1); STAGE(SA(0, 0), A, 0, t + 2);
    BAR; WAIT_L(0); MMA(1, 0, At, B0); BAR; SCHED;
    STAGE(SB(0, 1), Bt, HALF, t + 2);
    WAIT_V(6); BAR; MMA(1, 1, At, B1); BAR;
    LDB(B0, 1, 0); SCHED; LDA(At, 1, 0); STAGE(SA(0, 1), A, HALF, t + 2);
    WAIT_L(8); BAR; WAIT_L(0); MMA(0, 0, At, B0); BAR; SCHED;
    LDB(B1, 1, 1); STAGE(SB(1, 0), Bt, 0, t + 3);
    BAR; WAIT_L(0); MMA(0, 1, At, B1); BAR;
    LDA(At, 1, 1); STAGE(SA(1, 0), A, 0, t + 3);
    BAR; WAIT_L(0); MMA(1, 0, At, B0); BAR; SCHED;
    STAGE(SB(1, 1), Bt, HALF, t + 3);
    WAIT_V(6); BAR; MMA(1, 1, At, B1); BAR;
  }
  {
    LDB(B0, 0, 0); LDA(At, 0, 0); STAGE(SA(1, 1), A, HALF, nt - 1);
    BAR; WAIT_L(0); MMA(0, 0, At, B0); BAR;
    LDB(B1, 0, 1); BAR; WAIT_L(0); MMA(0, 1, At, B1); BAR;
    LDA(At, 0, 1); WAIT_V(4); BAR; WAIT_L(0); MMA(1, 0, At, B0); MMA(1, 1, At, B1); BAR;
  }
  {
    LDB(B0, 1, 0); LDA(At, 1, 0); WAIT_V(2); BAR; WAIT_L(0); MMA(0, 0, At, B0); BAR;
    LDB(B1, 1, 1); WAIT_V(0); BAR; WAIT_L(0); MMA(0, 1, At, B1); BAR;
    LDA(At, 1, 1); BAR; WAIT_L(0); MMA(1, 0, At, B0); MMA(1, 1, At, B1); BAR;
  }
  if (wr == 0) BAR;
#undef SA
#undef SB
#undef STAGE
#undef LDA
#undef LDB
#undef MMA
}

constexpr int N_TPAIR = 72 + 32 + 8;
DI void weight_pair_item(const Params& p, int L, int it, unsigned char* sm, const int wave_s);
DI void sw_item(const Params& p, int L, int it, unsigned char* sm, const int wave_s);
constexpr int N_SWITEM = 16 * 5;
DI int mod_row(int m0) { return m0 < NCTX ? 0 : 1 + ((m0 - NCTX) >> 11); }


DI void phase_inproj(const Params& p, int l, unsigned char* sm, const int wave_s) {
  const ushort_t* WtIn = (const ushort_t*)(p.ws + opq_o(OFF_WTIN)) + (size_t)l * 2304 * 1024;
  const ushort_t* xg = (const ushort_t*)(p.ws + opq_o(OFF_XG));
  ushort_t* P = (ushort_t*)(p.ws + opq_o(OFF_P));
  const float* rowss = (const float*)(p.ws + opq_o(OFF_ROWSS));
  const float* swpart = (const float*)(p.ws + opq_o(OFF_SWPART));
  const float2* ropecs = (const float2*)(p.ws + opq_o(OFF_ROPE));
  {
    const int tid0 = TIDX;
    ((uint4*)(sm + L_ROPE))[tid0] = ((const uint4*)ropecs)[tid0];
  }
  for (int t = blockIdx.x; t < 9 * 48; t += gridDim.x) {
    const int pn = (t & 7) + 8 * ((t >> 3) / 9), pm = (t >> 3) % 9;
    const int brow = pm * 256, bcol = pn * 256;
    const bool lat = bcol >= NCTX;
    const int bidx = mod_row(bcol);
    f32x4 acc[2][2][4][2];
#pragma unroll
    for (int a = 0; a < 2; ++a)
#pragma unroll
      for (int b = 0; b < 2; ++b)
#pragma unroll
        for (int m = 0; m < 4; ++m)
#pragma unroll
          for (int n = 0; n < 2; ++n) acc[a][b][m][n] = (f32x4){0.f, 0.f, 0.f, 0.f};
    __syncthreads();
    {
      const int tid1 = TIDX;
      if (tid1 < 256) {
        const float* sp_ = swpart + (size_t)(l * 5 + bidx) * 2304 + brow + tid1;
        float s = 0.f;
#pragma unroll
        for (int kc = 0; kc < 16; ++kc) s += sp_[(size_t)kc * 46080];
        ((float*)(sm + L_SW))[tid1] = s;
      } else {
        const int tl = tid1 - 256;
        const float4* rs = (const float4*)(rowss + (size_t)(bcol + tl) * 8);
        const float4 s0 = rs[0], s1 = rs[1];
        const float ss = ((s0.x + s0.y) + (s0.z + s0.w)) + ((s1.x + s1.y) + (s1.z + s1.w));
        ((float*)(sm + L_RR))[tl] = rsqrtf(ss * (1.f / 1024.f) + EPS);
      }
    }
    gemm256(WtIn + (size_t)brow * 1024, xg + (size_t)bcol * 1024, acc, sm, [](f32x4(&)[2][2][4][2]) {}, wave_s);
    const int tid2 = TIDX, wid2 = tid2 >> 6, lane2 = tid2 & 63;
    const int wr = wid2 >> 2, wc = wid2 & 3, fr = lane2 & 15, fq = lane2 >> 4;
    const float* swt = (const float*)(sm + L_SW);
    const float* rrt = (const float*)(sm + L_RR);
    const float2* ropeL = (const float2*)(sm + L_ROPE);
#pragma unroll
    for (int bj = 0; bj < 2; ++bj)
#pragma unroll
      for (int n = 0; n < 2; ++n) {
        const int tloc = bj * 128 + wc * 32 + n * 16 + fr;
        const int tk = bcol + tloc;
        const float rr = rrt[tloc];
        const int tpos = (tk - NCTX) & 2047;
#pragma unroll
        for (int ai = 0; ai < 2; ++ai) {
          const int floc = ai * 128 + wr * 64;
          const int f0 = brow + floc;
          float v[4][4];
#pragma unroll
          for (int m = 0; m < 4; ++m) {
            const float4 sv = *(const float4*)(swt + floc + m * 16 + fq * 4);
            v[m][0] = acc[ai][bj][m][n][0] * rr + sv.x;
            v[m][1] = acc[ai][bj][m][n][1] * rr + sv.y;
            v[m][2] = acc[ai][bj][m][n][2] * rr + sv.z;
            v[m][3] = acc[ai][bj][m][n][3] * rr + sv.w;
          }
          if (lat && f0 < 640) {
#pragma unroll
            for (int hlf = 0; hlf < 2; ++hlf) {
              const int pos = hlf == 0 ? (tpos >> 6) : (tpos & 63);
              const float4* cp = (const float4*)(ropeL + pos * 16 + fq * 4);
              const float4 c01 = cp[0], c23 = cp[1];
              const float cs_[4] = {c01.x, c01.z, c23.x, c23.z};
              const float sn_[4] = {c01.y, c01.w, c23.y, c23.w};
#pragma unroll
              for (int e = 0; e < 4; ++e) {
                const float x1 = v[2 * hlf][e], x2 = v[2 * hlf + 1][e];
                v[2 * hlf][e] = x1 * cs_[e] - x2 * sn_[e];
                v[2 * hlf + 1][e] = x2 * cs_[e] + x1 * sn_[e];
              }
            }
          }
          const float qs = f0 < 512 ? 0.125f * LOG2E : 1.f;
#pragma unroll
          for (int m = 0; m < 4; ++m) {
            uint2 o;
            o.x = pack2(v[m][0] * qs, v[m][1] * qs);
            o.y = pack2(v[m][2] * qs, v[m][3] * qs);
            *(uint2*)(P + (size_t)tk * INW + f0 + m * 16 + fq * 4) = o;
          }
          const int f128 = f0 >> 7;
          if (!lat && (f128 == 4 || f128 == 5)) {
            const int b = tk >> 8, s = tk & 255;
            float* dst = p.out + (size_t)12582912 + (f128 == 5 ? (size_t)2097152 : 0) +
                         ((size_t)((b * 4 + l) * 256 + s)) * 128 + (f0 & 127);
#pragma unroll
            for (int m = 0; m < 4; ++m)
              *(float4*)(dst + m * 16 + fq * 4) = make_float4(v[m][0], v[m][1], v[m][2], v[m][3]);
          }
        }
      }
  }
}

DI void phase_outproj(const Params& p, int l, unsigned char* sm, const int wave_s) {
  const ushort_t* WtOut = (const ushort_t*)(p.ws + opq_o(OFF_WTOUT)) + (size_t)l * 1024 * 1024;
  const ushort_t* am = (const ushort_t*)(p.ws + opq_o(OFF_AM));
  ushort_t* xg = (ushort_t*)(p.ws + opq_o(OFF_XG));
  float* xws = (float*)(p.ws + opq_o(OFF_X));
  const float* xprev = xws;
  float* rowss = (float*)(p.ws + opq_o(OFF_ROWSS));
  const float* ssa = (const float*)(p.ws + opq_o(OFF_SSA));
  const float* ssp = (const float*)(p.ws + opq_o(OFF_SSP));
  const float* mod = (const float*)(p.ws + opq_o(OFF_MOD));
  for (int t = blockIdx.x; t < 4 * 48; t += gridDim.x) {
    const int pn = (t & 7) + 8 * ((t >> 3) >> 2), pm = (t >> 3) & 3;
    const int brow = pm * 256, bcol = pn * 256;
    const int bidx = mod_row(bcol);
    f32x4 acc[2][2][4][2];
#pragma unroll
    for (int a = 0; a < 2; ++a)
#pragma unroll
      for (int b = 0; b < 2; ++b)
#pragma unroll
        for (int m = 0; m < 4; ++m)
#pragma unroll
          for (int n = 0; n < 2; ++n) acc[a][b][m][n] = (f32x4){0.f, 0.f, 0.f, 0.f};
    __syncthreads();
    {
      const int tid1 = TIDX;
      if (tid1 < 256) {
        const int tk = bcol + tid1;
        const float4* pa = (const float4*)(ssa + (size_t)tk * 8);
        const float4* pp = (const float4*)(ssp + (size_t)tk * 8);
        const float4 a0 = pa[0], a1 = pa[1], b0 = pp[0], b1 = pp[1];
        const float sa_ = ((a0.x + a0.y) + (a0.z + a0.w)) + ((a1.x + a1.y) + (a1.z + a1.w));
        const float sp_ = ((b0.x + b0.y) + (b0.z + b0.w)) + ((b1.x + b1.y) + (b1.z + b1.w));
        const float ra = rsqrtf(sa_ * (1.f / 512.f) + EPS), rpv = rsqrtf(sp_ * (1.f / 512.f) + EPS);
        ((float*)(sm + L_RATIO))[tid1] = ra / rpv;
        ((float*)(sm + L_RP))[tid1] = rpv;
      } else {
        const int f = brow + tid1 - 256;
        const float gt = mod[(size_t)(l * 5 + bidx) * 3072 + 2048 + f];
        float gn = 0.f;
        if (l < 3) gn = p.norm_w[(size_t)(l + 1) * 1024 + f] * (1.f + mod[(size_t)((l + 1) * 5 + bidx) * 3072 + 1024 + f]);
        ((float2*)(sm + L_GG))[tid1 - 256] = make_float2(gt, gn);
      }
    }
    gemm256(WtOut + (size_t)brow * 1024, am + (size_t)bcol * 1024, acc, sm, [&](f32x4(&ac)[2][2][4][2]) {
      const int tidm = TIDX;
      const float* rt = (const float*)(sm + L_RATIO) + ((tidm >> 6) & 3) * 32 + (tidm & 15);
#pragma unroll
      for (int b = 0; b < 2; ++b)
#pragma unroll
        for (int n = 0; n < 2; ++n) {
          const float rv = rt[b * 128 + n * 16];
#pragma unroll
          for (int a = 0; a < 2; ++a)
#pragma unroll
            for (int m = 0; m < 4; ++m) ac[a][b][m][n] *= rv;
          __builtin_amdgcn_sched_barrier(0);
        }
    }, wave_s);
    const int tid2 = TIDX, wid2 = tid2 >> 6, lane2 = tid2 & 63;
    const int wr = wid2 >> 2, wc = wid2 & 3, fr = lane2 & 15, fq = lane2 >> 4;
    const int tk0 = bcol + wc * 32 + fr;
    const float* xsrc0 = (l == 0) ? (tk0 < NCTX ? p.x_prompt + (size_t)tk0 * 1024 : p.x_sample + (size_t)(tk0 - NCTX) * 1024)
                                  : xprev + (size_t)tk0 * 1024;
    const float* rpt = (const float*)(sm + L_RP) + wc * 32 + fr;
    const float rp[2][2] = {{rpt[0], rpt[16]}, {rpt[128], rpt[144]}};
    const float4* ggt = (const float4*)(sm + L_GG);
    float ssq[2][2] = {{0.f, 0.f}, {0.f, 0.f}};
#pragma unroll
    for (int ai = 0; ai < 2; ++ai) {
      float4 xv[4][2][2];
#pragma unroll
      for (int m = 0; m < 4; ++m)
#pragma unroll
        for (int bj = 0; bj < 2; ++bj)
#pragma unroll
          for (int n = 0; n < 2; ++n)
            xv[m][bj][n] = *(const float4*)(xsrc0 + (size_t)(bj * 128 + n * 16) * 1024 + brow + ai * 128 + wr * 64 + m * 16 + fq * 4);
#pragma unroll
      for (int m = 0; m < 4; ++m) {
        const int floc = ai * 128 + wr * 64 + m * 16 + fq * 4;
        const int f = brow + floc;
        const float4 g01 = ggt[(floc >> 1)], g23 = ggt[(floc >> 1) + 1];
#pragma unroll
        for (int bj = 0; bj < 2; ++bj)
#pragma unroll
          for (int n = 0; n < 2; ++n) {
            const int toff = bj * 128 + n * 16;
            const float rpv = rp[bj][n];
            const float4 x4 = xv[m][bj][n];
            float4 xn;
            xn.x = x4.x + g01.x * (acc[ai][bj][m][n][0] * rpv);
            xn.y = x4.y + g01.z * (acc[ai][bj][m][n][1] * rpv);
            xn.z = x4.z + g23.x * (acc[ai][bj][m][n][2] * rpv);
            xn.w = x4.w + g23.z * (acc[ai][bj][m][n][3] * rpv);
            ssq[bj][n] += (xn.x * xn.x + xn.y * xn.y) + (xn.z * xn.z + xn.w * xn.w);
            *(float4*)(xws + (size_t)(tk0 + toff) * 1024 + f) = xn;
            if (l < 3) {
              uint2 o;
              o.x = pack2(xn.x * g01.y, xn.y * g01.w);
              o.y = pack2(xn.z * g23.y, xn.w * g23.w);
              *(uint2*)(xg + (size_t)(tk0 + toff) * 1024 + f) = o;
            }
          }
      }
      __builtin_amdgcn_sched_barrier(0);
    }
#pragma unroll
    for (int bj = 0; bj < 2; ++bj)
#pragma unroll
      for (int n = 0; n < 2; ++n) {
        float s = ssq[bj][n];
        s += __shfl_xor(s, 16);
        s += __shfl_xor(s, 32);
        if (fq == 0) rowss[(size_t)(tk0 + bj * 128 + n * 16) * 8 + pm * 2 + wr] = s;
      }
  }
}

constexpr int AT_KS_BYTES = 320 * 144;
typedef short v4i16_t __attribute__((ext_vector_type(4)));
DI s16x4 lds_tr_read(const unsigned char* q) {
  return __builtin_bit_cast(s16x4, __builtin_amdgcn_ds_read_tr16_b64_v4i16((LAS v4i16_t*)q));
}
DI void attn_tiles(const unsigned char* Ks, const unsigned char* Vt, int ntile, bool masked, int kbase, int qpos,
                   const bf16x8 (&qf)[4], float& m_run, float& l_run, f32x16 (&o)[2], int r, int h) {
  const int qa = qpos - r;
#pragma unroll 1
  for (int t = 0; t < ntile; ++t) {
    f32x16 s[2];
#pragma unroll
    for (int kt = 0; kt < 2; ++kt) {
#pragma unroll
      for (int i = 0; i < 16; ++i) s[kt][i] = 0.f;
      const unsigned char* kb = Ks + (t * 64 + kt * 32 + r) * 144 + h * 16;
#pragma unroll
      for (int ks = 0; ks < 4; ++ks) {
        const bf16x8 a = *(const bf16x8*)(kb + ks * 32);
        s[kt] = MFMA32(a, qf[ks], s[kt]);
      }
    }
    float mx = -3.0e38f;
    const int kb = kbase + t * 64;
    if (masked && (kb < qa - 97 || kb > qa + 65)) {
#pragma unroll
      for (int kt = 0; kt < 2; ++kt)
#pragma unroll
        for (int i = 0; i < 16; ++i) {
          const int d = qpos - (kb + kt * 32 + crow(i, h));
          float tv = s[kt][i];
          tv = (d > 128 || d < -128) ? -1.0e30f : tv;
          s[kt][i] = tv;
          mx = fmaxf(mx, tv);
        }
    } else {
#pragma unroll
      for (int kt = 0; kt < 2; ++kt)
#pragma unroll
        for (int i = 0; i < 16; ++i) mx = fmaxf(mx, s[kt][i]);
    }
    mx = fmaxf(mx, __shfl_xor(mx, 32));
    const float m_new = fmaxf(m_run, mx);
    const float alpha = __builtin_amdgcn_exp2f(m_run - m_new);
    m_run = m_new;
    f2_t ps2 = {0.f, 0.f};
    const f2_t mm2 = {m_new, m_new};
#pragma unroll
    for (int kt = 0; kt < 2; ++kt)
#pragma unroll
      for (int i = 0; i < 16; i += 2) {
        f2_t v2 = {s[kt][i], s[kt][i + 1]};
        v2 = v2 - mm2;
        f2_t e2 = {__builtin_amdgcn_exp2f(v2.x), __builtin_amdgcn_exp2f(v2.y)};
        s[kt][i] = e2.x;
        s[kt][i + 1] = e2.y;
        ps2 = ps2 + e2;
      }
    const float psum = ps2.x + ps2.y;
    l_run = l_run * alpha + psum;
#pragma unroll
    for (int i = 0; i < 16; ++i) { o[0][i] *= alpha; o[1][i] *= alpha; }
    bf16x8 pf[4];
#pragma unroll
    for (int st = 0; st < 4; ++st) {
      const int kt = st >> 1, s8 = (st & 1) * 8;
      uint4 u;
      u.x = pack2(s[kt][s8 + 0], s[kt][s8 + 1]);
      u.y = pack2(s[kt][s8 + 2], s[kt][s8 + 3]);
      u.z = pack2(s[kt][s8 + 4], s[kt][s8 + 5]);
      u.w = pack2(s[kt][s8 + 6], s[kt][s8 + 7]);
      pf[st] = __builtin_bit_cast(bf16x8, u);
    }
    const int l16 = r & 15;
    const unsigned char* vb = Vt + (t * 64 + 4 * h + (l16 >> 2)) * 144 + ((r >> 4) * 16 + 4 * (l16 & 3)) * 2;
#pragma unroll
    for (int dt = 0; dt < 2; ++dt)
#pragma unroll
      for (int st = 0; st < 4; ++st) {
        const s16x4 lo = lds_tr_read(vb + (16 * st) * 144 + dt * 64);
        const s16x4 hi = lds_tr_read(vb + (16 * st + 8) * 144 + dt * 64);
        const bf16x8 a = __builtin_shufflevector(lo, hi, 0, 1, 2, 3, 4, 5, 6, 7);
        o[dt] = MFMA32(a, pf[st], o[dt]);
      }
  }
}

DI void vt_store(unsigned char* Vt, int key, int ch, const uint4& vr) { *(uint4*)(Vt + key * 144 + ch * 16) = vr; }

DI void attn_item(const Params& p, int l, int item, unsigned char* sm, const int wave_s) {
  const ushort_t* P = (const ushort_t*)(p.ws + opq_o(OFF_P));
  ushort_t* am = (ushort_t*)(p.ws + opq_o(OFF_AM));
  float* ssa = (float*)(p.ws + opq_o(OFF_SSA));
  const int tid = TIDX, wave = tid >> 6, lane = tid & 63, r = lane & 31, h = lane >> 5;
  int b, kvh, q0, tokbase, klo, nkb;
  bool lat;
  if (item < 256) {
    lat = true;
    b = item >> 6;
    kvh = (item >> 5) & 1;
    q0 = (item & 31) * 64;
    tokbase = NCTX + b * 2048;
    klo = q0 - 128 < 0 ? 0 : q0 - 128;
    const int khi = q0 + 192 > 2048 ? 2048 : q0 + 192;
    nkb = khi - klo;
  } else {
    const int it = item - 256;
    lat = false;
    b = it >> 3;
    kvh = (it >> 2) & 1;
    q0 = (it & 3) * 64;
    tokbase = b * 256;
    klo = 0;
    nkb = 256;
  }
  const int hq = kvh * 4 + (wave & 3);
  const int qloc = q0 + (wave >> 2) * 32 + r;
  unsigned char* Ks = sm;
  unsigned char* Vt = sm + AT_KS_BYTES;
  {
    const int nch = nkb * 8;
    uint4 kr[5], vr[5];
#pragma unroll
    for (int i = 0; i < 5; ++i) {
      const int c = tid + i * 512;
      const int cc = c < nch ? c : nch - 1;
      const size_t tok = (size_t)(tokbase + klo + (cc >> 3));
      kr[i] = *(const uint4*)(P + tok * INW + 512 + kvh * 64 + (cc & 7) * 8);
      vr[i] = *(const uint4*)(P + tok * INW + 640 + kvh * 64 + (cc & 7) * 8);
    }
#pragma unroll
    for (int i = 0; i < 5; ++i) {
      const int c = tid + i * 512;
      if (c < nch) {
        *(uint4*)(Ks + (c >> 3) * 144 + (c & 7) * 16) = kr[i];
        vt_store(Vt, c >> 3, c & 7, vr[i]);
      }
    }
  }
  bf16x8 qf[4];
  {
    const ushort_t* qp = P + (size_t)(tokbase + qloc) * INW + hq * 64 + h * 8;
#pragma unroll
    for (int ks = 0; ks < 4; ++ks) qf[ks] = *(const bf16x8*)(qp + ks * 16);
  }
  uint2 gav[2][4];
  float4 anw[2][4];
  {
    const ushort_t* gp_ = P + (size_t)(tokbase + qloc) * INW + 768 + hq * 64 + 4 * h;
#pragma unroll
    for (int dt = 0; dt < 2; ++dt)
#pragma unroll
      for (int g = 0; g < 4; ++g) {
        gav[dt][g] = *(const uint2*)(gp_ + dt * 32 + 8 * g);
        anw[dt][g] = *(const float4*)(p.attn_norm + l * 512 + hq * 64 + dt * 32 + 8 * g + 4 * h);
      }
  }
  float m_run = p.sink[l * 8 + hq] * LOG2E;
  float l_run = (h == 0) ? 1.f : 0.f;
  f32x16 o[2];
#pragma unroll
  for (int i = 0; i < 16; ++i) { o[0][i] = 0.f; o[1][i] = 0.f; }
  uint4 ck[4], cv[4];
#pragma unroll
  for (int i = 0; i < 4; ++i) { ck[i] = make_uint4(0, 0, 0, 0); cv[i] = make_uint4(0, 0, 0, 0); }
  if (lat) {
    const size_t base = (size_t)((b * 4 + l) * 256);
#pragma unroll
    for (int i = 0; i < 4; ++i) {
      const int c = tid + i * 512;
      const int key = c >> 3, ch = c & 7;
      const float4* kp = (const float4*)(p.cache_k + (base + key) * 128 + kvh * 64 + ch * 8);
      const float4* vp = (const float4*)(p.cache_v + (base + key) * 128 + kvh * 64 + ch * 8);
      const float4 k0 = kp[0], k1 = kp[1], v0 = vp[0], v1 = vp[1];
      ck[i] = make_uint4(pack2(k0.x, k0.y), pack2(k0.z, k0.w), pack2(k1.x, k1.y), pack2(k1.z, k1.w));
      cv[i] = make_uint4(pack2(v0.x, v0.y), pack2(v0.z, v0.w), pack2(v1.x, v1.y), pack2(v1.z, v1.w));
    }
  }
  __syncthreads();
  attn_tiles(Ks, Vt, nkb >> 6, lat, klo, qloc, qf, m_run, l_run, o, r, h);
  if (lat) {
    __syncthreads();
#pragma unroll
    for (int i = 0; i < 4; ++i) {
      const int c = tid + i * 512;
      const int key = c >> 3, ch = c & 7;
      *(uint4*)(Ks + key * 144 + ch * 16) = ck[i];
      vt_store(Vt, key, ch, cv[i]);
    }
    __syncthreads();
    attn_tiles(Ks, Vt, 4, false, 0, qloc, qf, m_run, l_run, o, r, h);
  }
  const float l_tot = l_run + __shfl_xor(l_run, 32);
  const float inv = 1.f / l_tot;
  const size_t m = (size_t)(tokbase + qloc);
  const float* an = p.attn_norm + l * 512 + hq * 64;
  float ssq = 0.f;
#pragma unroll
  for (int dt = 0; dt < 2; ++dt)
#pragma unroll
    for (int g = 0; g < 4; ++g) {
      const int d = dt * 32 + 8 * g + 4 * h;
      const uint2 gavv = gav[dt][g];
      const float4 w4 = anw[dt][g];
      const float o0 = o[dt][4 * g + 0] * inv, o1 = o[dt][4 * g + 1] * inv, o2 = o[dt][4 * g + 2] * inv,
                  o3 = o[dt][4 * g + 3] * inv;
      ssq += (o0 * o0 + o1 * o1) + (o2 * o2 + o3 * o3);
      uint2 ov;
      ov.x = pack2(o0 * w4.x * silu_f(bflo(gavv.x)), o1 * w4.y * silu_f(bfhi(gavv.x)));
      ov.y = pack2(o2 * w4.z * silu_f(bflo(gavv.y)), o3 * w4.w * silu_f(bfhi(gavv.y)));
      *(uint2*)(am + m * 1024 + hq * 64 + d) = ov;
    }
  ssq += __shfl_xor(ssq, 32);
  if (h == 0) ssa[m * 8 + hq] = ssq;
}

template <int HALF>
DI void pool_window(const unsigned char* U, unsigned char* Pm, int t0, int L, int tid) {
  const int cp = tid & 63, seg = tid >> 6;
  const int tl0 = seg * 16;
  const unsigned char* up = U + (tl0 + 8 - HALF) * 272 + cp * 4;
  float s0 = 0.f, s1 = 0.f;
#pragma unroll
  for (int j = 0; j < 2 * HALF; ++j) {
    const unsigned u = *(const unsigned*)(up + j * 272);
    s0 += bflo(u);
    s1 += bfhi(u);
  }
#pragma unroll
  for (int i = 0; i < 16; ++i) {
    const int tl = tl0 + i;
    const int t = t0 + tl;
    const int lo = t - HALF < 0 ? 0 : t - HALF;
    const int hi = t + HALF > L ? L : t + HALF;
    const unsigned xc = *(const unsigned*)(U + (tl + 8) * 272 + cp * 4);
    const float invc = 1.f / (float)(hi - lo);
    *(unsigned*)(Pm + tl * 272 + cp * 4) = pack2(s0 * invc - bflo(xc), s1 * invc - bfhi(xc));
    if (i < 15) {
      const unsigned ua = *(const unsigned*)(up + (i + 2 * HALF) * 272);
      const unsigned ub = *(const unsigned*)(up + i * 272);
      s0 += bflo(ua) - bflo(ub);
      s1 += bfhi(ua) - bfhi(ub);
    }
  }
}

DI void pool_item(const Params& p, int l, int item, unsigned char* sm, const int wave_s) {
  const ushort_t* P = (const ushort_t*)(p.ws + opq_o(OFF_P));
  ushort_t* am = (ushort_t*)(p.ws + opq_o(OFF_AM));
  float* ssp = (float*)(p.ws + opq_o(OFF_SSP));
  const ushort_t* Wp = (const ushort_t*)(p.ws + opq_o(OFF_WTPOOL));
  const int tid = TIDX, wave = tid >> 6, lane = tid & 63, r = lane & 31, h = lane >> 5;
  const int tt = item >> 2, g = item & 3;
  const int m0 = tt * 128;
  int L, sbase;
  if (m0 < NCTX) { L = 256; sbase = m0 & ~255; } else { L = 2048; sbase = NCTX + ((m0 - NCTX) & ~2047); }
  const int t0 = m0 - sbase;
  unsigned char* U = sm;
  unsigned char* W = sm + 39168;
  unsigned char* Pm = sm + 39168 + 34816;
  const ushort_t* wsrc = Wp + (size_t)(l * 4 + g) * 128 * 128;
  {
    uint4 uu[5], ww[4];
#pragma unroll
    for (int i = 0; i < 5; ++i) {
      const int c = tid + i * 512;
      const int row = c >> 4, ch = c & 15;
      const int pos = t0 - 8 + row;
      uu[i] = make_uint4(0, 0, 0, 0);
      if (c < 144 * 16 && pos >= 0 && pos < L) uu[i] = *(const uint4*)(P + (size_t)(sbase + pos) * INW + 1280 + g * 128 + ch * 8);
    }
#pragma unroll
    for (int i = 0; i < 4; ++i) {
      const int c = tid + i * 512;
      ww[i] = *(const uint4*)(wsrc + (c >> 4) * 128 + (c & 15) * 8);
    }
#pragma unroll
    for (int i = 0; i < 5; ++i) {
      const int c = tid + i * 512;
      if (c < 144 * 16) *(uint4*)(U + (c >> 4) * 272 + (c & 15) * 16) = uu[i];
    }
#pragma unroll
    for (int i = 0; i < 4; ++i) {
      const int c = tid + i * 512;
      *(uint4*)(W + (c >> 4) * 272 + (c & 15) * 16) = ww[i];
    }
  }
  const int wm = wave & 3, wn = wave >> 2;
  const size_t m = (size_t)(m0 + wm * 32 + r);
  uint2 gpv_[2][4];
  float4 ps_[2][4], pn_[2][4];
#pragma unroll
  for (int nt = 0; nt < 2; ++nt)
#pragma unroll
    for (int gq = 0; gq < 4; ++gq)
    {
      const int c_ = g * 128 + wn * 64 + nt * 32 + 8 * gq + 4 * h;
      gpv_[nt][gq] = *(const uint2*)(P + m * INW + 1792 + c_);
      ps_[nt][gq] = *(const float4*)(p.pool_scale + l * 512 + c_);
      pn_[nt][gq] = *(const float4*)(p.pool_norm + l * 512 + c_);
    }
  __syncthreads();
  switch (g) {
    case 0: pool_window<1>(U, Pm, t0, L, tid); break;
    case 1: pool_window<2>(U, Pm, t0, L, tid); break;
    case 2: pool_window<4>(U, Pm, t0, L, tid); break;
    default: pool_window<8>(U, Pm, t0, L, tid); break;
  }
  __syncthreads();
  f32x16 acc[2];
#pragma unroll
  for (int i = 0; i < 16; ++i) { acc[0][i] = 0.f; acc[1][i] = 0.f; }
  const unsigned char* wa = W + (wn * 64 + r) * 272 + h * 16;
  const unsigned char* pb = Pm + (wm * 32 + r) * 272 + h * 16;
#pragma unroll
  for (int ks = 0; ks < 8; ++ks) {
    const bf16x8 bq = *(const bf16x8*)(pb + ks * 32);
    const bf16x8 a0 = *(const bf16x8*)(wa + ks * 32);
    const bf16x8 a1 = *(const bf16x8*)(wa + 32 * 272 + ks * 32);
    acc[0] = MFMA32(a0, bq, acc[0]);
    acc[1] = MFMA32(a1, bq, acc[1]);
  }
  float ssq = 0.f;
#pragma unroll
  for (int nt = 0; nt < 2; ++nt)
#pragma unroll
    for (int gq = 0; gq < 4; ++gq) {
      const int c = g * 128 + wn * 64 + nt * 32 + 8 * gq + 4 * h;
      const float4 ps = ps_[nt][gq];
      const float4 pn = pn_[nt][gq];
      const uint2 gpv = gpv_[nt][gq];
      const float o0 = acc[nt][4 * gq + 0] * ps.x, o1 = acc[nt][4 * gq + 1] * ps.y, o2 = acc[nt][4 * gq + 2] * ps.z,
                  o3 = acc[nt][4 * gq + 3] * ps.w;
      ssq += (o0 * o0 + o1 * o1) + (o2 * o2 + o3 * o3);
      uint2 ov;
      ov.x = pack2(o0 * pn.x * silu_f(bflo(gpv.x)), o1 * pn.y * silu_f(bfhi(gpv.x)));
      ov.y = pack2(o2 * pn.z * silu_f(bflo(gpv.y)), o3 * pn.w * silu_f(bfhi(gpv.y)));
      *(uint2*)(am + m * 1024 + 512 + c) = ov;
    }
  ssq += __shfl_xor(ssq, 32);
  if (h == 0) ssp[m * 8 + g * 2 + wn] = ssq;
}

DI void transpose_item(const float* __restrict__ src, ushort_t* __restrict__ dst, int R, int C, int r0, int c0,
                       unsigned char* sm, int t256) {
  float* T = (float*)sm;
  const int rr = t256 >> 4, cc4 = (t256 & 15) * 4;
#pragma unroll
  for (int i = 0; i < 4; ++i) {
    const int row = rr + 16 * i;
    const float4 v = *(const float4*)(src + (size_t)(r0 + row) * C + c0 + cc4);
    T[row * 65 + cc4 + 0] = v.x;
    T[row * 65 + cc4 + 1] = v.y;
    T[row * 65 + cc4 + 2] = v.z;
    T[row * 65 + cc4 + 3] = v.w;
  }
  __syncthreads();
  const int c = t256 >> 2, rseg = (t256 & 3) * 16;
  uint4 o0, o1;
  o0.x = pack2(T[(rseg + 0) * 65 + c], T[(rseg + 1) * 65 + c]);
  o0.y = pack2(T[(rseg + 2) * 65 + c], T[(rseg + 3) * 65 + c]);
  o0.z = pack2(T[(rseg + 4) * 65 + c], T[(rseg + 5) * 65 + c]);
  o0.w = pack2(T[(rseg + 6) * 65 + c], T[(rseg + 7) * 65 + c]);
  o1.x = pack2(T[(rseg + 8) * 65 + c], T[(rseg + 9) * 65 + c]);
  o1.y = pack2(T[(rseg + 10) * 65 + c], T[(rseg + 11) * 65 + c]);
  o1.z = pack2(T[(rseg + 12) * 65 + c], T[(rseg + 13) * 65 + c]);
  o1.w = pack2(T[(rseg + 14) * 65 + c], T[(rseg + 15) * 65 + c]);
  ushort_t* d = dst + (size_t)(c0 + c) * R + r0 + rseg;
  *(uint4*)d = o0;
  *(uint4*)(d + 8) = o1;
}


DI void transpose_strip(const float* __restrict__ src, ushort_t* __restrict__ dst, int R, int C, int r0, int c0,
                        unsigned char* sm, int t256) {
  float* T = (float*)sm;
  const int rr = t256 >> 6, cc4 = (t256 & 63) * 4;
  float4 v[16];
#pragma unroll
  for (int i = 0; i < 16; ++i) v[i] = *(const float4*)(src + (size_t)(r0 + rr + 4 * i) * C + c0 + cc4);
#pragma unroll
  for (int i = 0; i < 16; ++i) {
    float* t = T + (rr + 4 * i) * 257 + cc4;
    t[0] = v[i].x; t[1] = v[i].y; t[2] = v[i].z; t[3] = v[i].w;
  }
  __syncthreads();
  ushort_t* d = dst + (size_t)(c0 + t256) * R + r0;
#pragma unroll
  for (int g = 0; g < 8; ++g) {
    uint4 o;
    o.x = pack2(T[(8 * g + 0) * 257 + t256], T[(8 * g + 1) * 257 + t256]);
    o.y = pack2(T[(8 * g + 2) * 257 + t256], T[(8 * g + 3) * 257 + t256]);
    o.z = pack2(T[(8 * g + 4) * 257 + t256], T[(8 * g + 5) * 257 + t256]);
    o.w = pack2(T[(8 * g + 6) * 257 + t256], T[(8 * g + 7) * 257 + t256]);
    *(uint4*)(d + 8 * g) = o;
  }
}

DI void weight_pair_item(const Params& p, int L, int it, unsigned char* sm, const int wave_s) {
  const int tid = TIDX;
  const int half = tid >> 8, t256 = tid & 255;
  if (it < 72) {
    const int it2 = it * 2 + half;
    const int rt = it2 / 9, ct = it2 % 9;
    transpose_strip(p.w_in + (size_t)L * 1024 * 2304, (ushort_t*)(p.ws + OFF_WTIN) + (size_t)L * 2304 * 1024, 1024, 2304,
                    rt * 64, ct * 256, sm + half * 65792, t256);
  } else if (it < 72 + 32) {
    const int it2 = (it - 72) * 2 + half;
    const int rt = it2 >> 2, ct = it2 & 3;
    transpose_strip(p.w_out + (size_t)L * 1024 * 1024, (ushort_t*)(p.ws + OFF_WTOUT) + (size_t)L * 1024 * 1024, 1024, 1024,
                    rt * 64, ct * 256, sm + half * 65792, t256);
  } else {
    const int it2 = (it - 72 - 32) * 2 + half;
    const int mat = L * 4 + (it2 >> 2), rt = (it2 >> 1) & 1, ct = it2 & 1;
    transpose_item(p.w_pool + (size_t)mat * 128 * 128, (ushort_t*)(p.ws + OFF_WTPOOL) + (size_t)mat * 128 * 128, 128, 128,
                   rt * 64, ct * 64, sm + half * 16640, t256);
  }
}

DI void mod_item(const Params& p, int L, int cg64, unsigned char* sm, const int wave_s) {
  const int tid = TIDX, wave = tid >> 6, lane = tid & 63;
  float* sv = (float*)sm;
  float* red = (float*)(sm + 20480);
  for (int idx = tid; idx < 5120; idx += 512) {
    const int rr = idx >> 10, k = idx & 1023;
    const float cv = rr == 0 ? p.c_ctx[k] : p.c[(rr - 1) * 1024 + k];
    sv[idx] = silu_f(cv);
  }
  __syncthreads();
  const int j = cg64 * 64 + lane;
  const float* wp = p.w_ada + ((size_t)L * 1024 + wave * 128) * 3072 + j;
  const float* s0 = sv + wave * 128;
  float a0 = 0.f, a1 = 0.f, a2 = 0.f, a3 = 0.f, a4 = 0.f;
#pragma unroll 8
  for (int kk = 0; kk < 128; ++kk) {
    const float w = wp[(size_t)kk * 3072];
    a0 += s0[kk] * w;
    a1 += s0[1024 + kk] * w;
    a2 += s0[2048 + kk] * w;
    a3 += s0[3072 + kk] * w;
    a4 += s0[4096 + kk] * w;
  }
  float* rd = red + (wave * 5) * 64 + lane;
  rd[0] = a0; rd[64] = a1; rd[128] = a2; rd[192] = a3; rd[256] = a4;
  __syncthreads();
  if (tid < 320) {
    const int rr = tid >> 6, c = tid & 63;
    float s = p.b_ada[L * 3072 + cg64 * 64 + c];
#pragma unroll
    for (int w = 0; w < 8; ++w) s += red[(w * 5 + rr) * 64 + c];
    ((float*)(p.ws + OFF_MOD))[(size_t)(L * 5 + rr) * 3072 + cg64 * 64 + c] = s;
  }
}

DI void sw_item(const Params& p, int L, int it, unsigned char* sm, const int wave_s) {
  const int tid = TIDX, half = tid >> 8, t256 = tid & 255;
  const int kc = it / 5, cgp = (it % 5) * 2 + half;
  const float* mod = (const float*)(p.ws + OFF_MOD);
  float* sh = (float*)sm + half * 320;
  for (int idx = t256; idx < 320; idx += 256) {
    const int rr = idx >> 6, kk = idx & 63;
    sh[idx] = mod[(size_t)(L * 5 + rr) * 3072 + kc * 64 + kk];
  }
  __syncthreads();
  if (cgp < 9) {
    const int n = cgp * 256 + t256;
    float a0 = 0.f, a1 = 0.f, a2 = 0.f, a3 = 0.f, a4 = 0.f;
    const float* wp = p.w_in + ((size_t)L * 1024 + kc * 64) * 2304 + n;
#pragma unroll 8
    for (int kk = 0; kk < 64; ++kk) {
      const float w = wp[(size_t)kk * 2304];
      a0 += sh[kk] * w;
      a1 += sh[64 + kk] * w;
      a2 += sh[128 + kk] * w;
      a3 += sh[192 + kk] * w;
      a4 += sh[256 + kk] * w;
    }
    float* sp = (float*)(p.ws + OFF_SWPART) + ((size_t)(kc * 4 + L) * 5) * 2304 + n;
    sp[0] = a0; sp[2304] = a1; sp[2 * 2304] = a2; sp[3 * 2304] = a3; sp[4 * 2304] = a4;
  }
}

DI void sincos_d(double a, double& sn, double& cs) {
  const double twopi = 6.283185307179586476925;
  const double n = rint(a / twopi);
  const double x = a - n * twopi;
  const double x2 = x * x;
  double ts = x, tc = 1.0, s = x, c = 1.0;
#pragma unroll 1
  for (int k = 1; k <= 16; ++k) {
    tc = -tc * x2 / (double)((2 * k - 1) * (2 * k));
    ts = -ts * x2 / (double)((2 * k) * (2 * k + 1));
    c += tc;
    s += ts;
  }
  sn = s;
  cs = c;
}

__global__ void __launch_bounds__(512, 2) fwd_megakernel(Params p) {
  cg::grid_group grid = cg::this_grid();
  __shared__ __attribute__((aligned(16))) unsigned char sm[SMEM_TOTAL];
  uint4& xb_words = *(uint4*)(sm + L_XB);
  const int nblk = gridDim.x;
  const int wave_s = __builtin_amdgcn_readfirstlane((int)(threadIdx.x >> 6));
  if (p.ws == nullptr) grid.sync();
  const bool is_t0 = (TIDX == 0);
  if (is_t0) xb_words = make_uint4(0u, 0u, 0u, 0u);
  __syncthreads();
  (void)xcd_barrier_post((unsigned*)(p.ws + OFF_BAR), (volatile LAS unsigned*)&xb_words, is_t0);
#define GRID_SYNC()                                            \
  do {                                                         \
    XcdBarrier xb_;                                            \
    xb_.bar = (unsigned*)(p.ws + opq_o(OFF_BAR));              \
    xb_.x = xb_xcc_id();                                       \
    xb_.st = (volatile LAS unsigned*)&xb_words;                \
    xcd_barrier(xb_, TIDX == 0);                               \
  } while (0)

  {
    const int tid = TIDX;
    constexpr int TOTAL = 4 * N_TPAIR + 4 * 48 + 1;
    for (int item = blockIdx.x; item < TOTAL; item += nblk) {
      __syncthreads();
      if (item < 4 * N_TPAIR) {
        weight_pair_item(p, item / N_TPAIR, item % N_TPAIR, sm, wave_s);
      } else if (item < 4 * N_TPAIR + 192) {
        mod_item(p, (item - 4 * N_TPAIR) / 48, (item - 4 * N_TPAIR) % 48, sm, wave_s);
      } else {
        float2* rc = (float2*)(p.ws + OFF_ROPE);
        for (int idx = tid; idx < 1024; idx += 512) {
          const int pos = idx >> 4, fi = idx & 15;
          const float inv = __builtin_amdgcn_exp2f(-(float)fi * (1.f / 16.f) * 13.287712379549449f);
          const float ang = (float)pos * inv;
          double sn, cs;
          sincos_d((double)ang, sn, cs);
          rc[idx] = make_float2((float)cs, (float)sn);
        }
      }
    }
  }
  GRID_SYNC();
  {
    for (int item = blockIdx.x; item < 4 * N_SWITEM; item += nblk) {
      __syncthreads();
      sw_item(p, item / N_SWITEM, item % N_SWITEM, sm, wave_s);
    }
    const float* mod = (const float*)(p.ws + OFF_MOD);
    ushort_t* xg = (ushort_t*)(p.ws + OFF_XG);
    float* rowss = (float*)(p.ws + OFF_ROWSS);
    const int tidr = TIDX, lane = tidr & 63;
    const int rstride = nblk * 8;
    for (int row0 = blockIdx.x * 8 + (tidr >> 6); row0 < NTOK; row0 += 6 * rstride) {
      float4 v[6][4];
      bool ok[6];
#pragma unroll
      for (int u = 0; u < 6; ++u) {
        const int row = row0 + u * rstride;
        ok[u] = row < NTOK;
        const int rw = ok[u] ? row : row0;
        const float* src = rw < NCTX ? p.x_prompt + (size_t)rw * 1024 : p.x_sample + (size_t)(rw - NCTX) * 1024;
#pragma unroll
        for (int i = 0; i < 4; ++i) v[u][i] = *(const float4*)(src + lane * 4 + 256 * i);
      }
#pragma unroll
      for (int u = 0; u < 6; ++u) {
        const int row = row0 + u * rstride;
        if (!ok[u]) continue;
        const float* scl = mod + (size_t)mod_row(row) * 3072 + 1024;
        float ss = 0.f;
#pragma unroll
        for (int i = 0; i < 4; ++i) {
          const int n = lane * 4 + 256 * i;
          const float4 x4 = v[u][i];
          const float4 sc = *(const float4*)(scl + n);
          const float4 w4 = *(const float4*)(p.norm_w + n);
          ss += (x4.x * x4.x + x4.y * x4.y) + (x4.z * x4.z + x4.w * x4.w);
          uint2 o;
          o.x = pack2(x4.x * (w4.x * (1.f + sc.x)), x4.y * (w4.y * (1.f + sc.y)));
          o.y = pack2(x4.z * (w4.z * (1.f + sc.z)), x4.w * (w4.w * (1.f + sc.w)));
          *(uint2*)(xg + (size_t)row * 1024 + n) = o;
        }
#pragma unroll
        for (int off = 32; off >= 1; off >>= 1) ss += __shfl_xor(ss, off);
        if (lane < 8) rowss[(size_t)row * 8 + lane] = lane == 0 ? ss : 0.f;
      }
    }
  }
  GRID_SYNC();
#pragma unroll 1
  for (int l = 0; l < 4; ++l) {
    phase_inproj(p, l, sm, wave_s);
    GRID_SYNC();
    if (nblk == 256) {
      const int xq = blockIdx.x & 7, rq = blockIdx.x >> 3;
      __syncthreads();
      attn_item(p, l, (rq >> 3) * 64 + ((rq >> 2) & 1) * 32 + 4 * xq + (rq & 3), sm, wave_s);
      __syncthreads();
      if (rq < 16) {
        attn_item(p, l, 256 + (xq + 8 * (rq >> 3)) * 8 + ((rq >> 2) & 1) * 4 + (rq & 3), sm, wave_s);
      } else {
        const int e = rq - 16;
        pool_item(p, l, (2 * (xq + 8 * (e >> 3)) + ((e >> 2) & 1)) * 4 + (e & 3), sm, wave_s);
      }
      __syncthreads();
      {
        const int e = 16 + rq;
        pool_item(p, l, (2 * (xq + 8 * (e >> 3)) + ((e >> 2) & 1)) * 4 + (e & 3), sm, wave_s);
      }
    } else {
      for (int item = blockIdx.x; item < 384 + 384; item += nblk) {
        __syncthreads();
        if (item < 384) attn_item(p, l, item, sm, wave_s);
        else pool_item(p, l, item - 384, sm, wave_s);
      }
    }
    GRID_SYNC();
    phase_outproj(p, l, sm, wave_s);
    GRID_SYNC();
  }
  {
    const float* xws = (const float*)(p.ws + OFF_X);
    const float* rowss = (const float*)(p.ws + OFF_ROWSS);
    const int tidr = TIDX, lane = tidr & 63;
    const int rstride = nblk * 8;
    for (int row0 = blockIdx.x * 8 + (tidr >> 6); row0 < NTOK; row0 += 6 * rstride) {
      float4 v[6][4];
      float rr[6];
#pragma unroll
      for (int u = 0; u < 6; ++u) {
        const int row = (row0 + u * rstride) < NTOK ? (row0 + u * rstride) : row0;
        const float4* rs = (const float4*)(rowss + (size_t)row * 8);
        const float4 s0 = rs[0], s1 = rs[1];
        rr[u] = rsqrtf((((s0.x + s0.y) + (s0.z + s0.w)) + ((s1.x + s1.y) + (s1.z + s1.w))) * (1.f / 1024.f) + EPS);
#pragma unroll
        for (int i = 0; i < 4; ++i) v[u][i] = *(const float4*)(xws + (size_t)row * 1024 + lane * 4 + 256 * i);
      }
#pragma unroll
      for (int u = 0; u < 6; ++u) {
        const int row = row0 + u * rstride;
        if (row >= NTOK) continue;
#pragma unroll
        for (int i = 0; i < 4; ++i) {
          const int n = lane * 4 + 256 * i;
          const float4 w4 = *(const float4*)(p.final_norm + n);
          const float4 x4 = v[u][i];
          *(float4*)(p.out + (size_t)row * 1024 + n) =
              make_float4(x4.x * rr[u] * w4.x, x4.y * rr[u] * w4.y, x4.z * rr[u] * w4.z, x4.w * rr[u] * w4.w);
        }
      }
    }
  }
}

extern "C" void kernel_launch(void* const* d_in, const int* in_sizes, int n_in, void* d_out, int out_size, void* d_ws,
                              size_t ws_size, hipStream_t stream) {
  static int grid_blocks = 0;
  if (!grid_blocks) {
    int dev = 0, cus = 0, per_cu = 0;
    (void)hipGetDevice(&dev);
    (void)hipDeviceGetAttribute(&cus, hipDeviceAttributeMultiprocessorCount, dev);
    (void)hipOccupancyMaxActiveBlocksPerMultiprocessor(&per_cu, fwd_megakernel, 512, 0);
    if (per_cu < 1) fprintf(stderr, "occupancy query reports %d blocks per CU\n", per_cu);
    grid_blocks = cus;
  }
  Params p{};
  p.x_prompt = (const float*)d_in[0];
  p.x_sample = (const float*)d_in[1];
  p.cache_k = (const float*)d_in[2];
  p.cache_v = (const float*)d_in[3];
  p.c = (const float*)d_in[4];
  p.c_ctx = (const float*)d_in[5];
  p.norm_w = (const float*)d_in[6];
  p.w_ada = (const float*)d_in[7];
  p.b_ada = (const float*)d_in[8];
  p.w_in = (const float*)d_in[9];
  p.sink = (const float*)d_in[10];
  p.attn_norm = (const float*)d_in[11];
  p.pool_norm = (const float*)d_in[12];
  p.w_pool = (const float*)d_in[13];
  p.pool_scale = (const float*)d_in[14];
  p.w_out = (const float*)d_in[15];
  p.final_norm = (const float*)d_in[16];
  p.out = (float*)d_out;
  p.ws = (unsigned char*)d_ws;
  (void)hipMemsetAsync((unsigned char*)d_ws + OFF_BAR, 0, XCD_BAR_WORDS * 4, stream);
  void* args[] = {&p};
  hipError_t e = hipLaunchCooperativeKernel((void*)fwd_megakernel, dim3(grid_blocks), dim3(512), args, 0, stream);
  if (e != hipSuccess) fprintf(stderr, "cooperative launch failed: %s (grid %d)\n", hipGetErrorString(e), grid_blocks);
}
```

```cpp
#include <hip/hip_runtime.h>
#include <hip/hip_cooperative_groups.h>
#include <cstdio>
namespace cg = cooperative_groups;

typedef __attribute__((ext_vector_type(8))) short bf16x8;
typedef __attribute__((ext_vector_type(4))) short s16x4;
typedef __attribute__((ext_vector_type(16))) float f32x16;
typedef __attribute__((ext_vector_type(4))) float f32x4;
typedef __bf16 bf2_t __attribute__((ext_vector_type(2)));
typedef float f2_t __attribute__((ext_vector_type(2)));
typedef unsigned short ushort_t;

#define DI __device__ __forceinline__
#define MFMA32(a, b, c) __builtin_amdgcn_mfma_f32_32x32x16_bf16((a), (b), (c), 0, 0, 0)

constexpr int NTOK = 12288, NCTX = 4096, DM = 1024, INW = 2304;
constexpr float EPS = 1e-6f;
constexpr float LOG2E = 1.4426950408889634f;

constexpr size_t OFF_WTIN = 0;
constexpr size_t OFF_WTOUT = OFF_WTIN + 4ull * 2304 * 1024 * 2;
constexpr size_t OFF_WTPOOL = OFF_WTOUT + 4ull * 1024 * 1024 * 2;
constexpr size_t OFF_MODPART = OFF_WTPOOL + 4ull * 4 * 128 * 128 * 2;
constexpr size_t OFF_MOD = OFF_MODPART + 16ull * 4 * 5 * 3072 * 4;
constexpr size_t OFF_SWPART = OFF_MOD + 4ull * 5 * 3072 * 4;
constexpr size_t OFF_SW = OFF_SWPART + 16ull * 4 * 5 * 2304 * 4;
constexpr size_t OFF_ROPE = OFF_SW + 4ull * 5 * 2304 * 4;
constexpr size_t OFF_X = OFF_ROPE + 64 * 16 * 8;
constexpr size_t OFF_XG = OFF_X + 12288ull * 1024 * 4;
constexpr size_t OFF_P = OFF_XG + 12288ull * 1024 * 2;
constexpr size_t OFF_AM = OFF_P + 12288ull * 2304 * 2;
constexpr size_t OFF_ROWSS = OFF_AM + 12288ull * 1024 * 2;
constexpr size_t OFF_SSA = OFF_ROWSS + 12288ull * 16 * 4;
constexpr size_t OFF_SSP = OFF_SSA + 12288ull * 8 * 4;
constexpr size_t OFF_BAR = OFF_SSP + 12288ull * 8 * 4;
constexpr size_t OFF_X1 = OFF_BAR + 16384;

constexpr int SMEM_BYTES = 131072;
constexpr int L_RATIO = SMEM_BYTES;
constexpr int L_RP = L_RATIO + 1024;
constexpr int L_GG = L_RP + 1024;
constexpr int L_SW = L_GG + 2048;
constexpr int L_RR = L_SW + 1024;
constexpr int L_ROPE = L_RR + 1024;
constexpr int L_XB = L_ROPE + 8192;
constexpr int SMEM_TOTAL = L_XB + 16;

struct Params {
  const float *x_prompt, *x_sample, *cache_k, *cache_v, *c, *c_ctx, *norm_w, *w_ada, *b_ada, *w_in, *sink, *attn_norm,
      *pool_norm, *w_pool, *pool_scale, *w_out, *final_norm;
  float* out;
  unsigned char* ws;
};

DI unsigned pack2(float a, float b) {
  f2_t v = {a, b};
  return __builtin_bit_cast(unsigned, __builtin_convertvector(v, bf2_t));
}
DI float bflo(unsigned u) { return __uint_as_float(u << 16); }
DI float bfhi(unsigned u) { return __uint_as_float(u & 0xffff0000u); }
DI float silu_f(float x) { return x / (1.f + __expf(-x)); }
DI int opq(int x) { asm volatile("" : "+v"(x)); return x; }
DI int lane_id_v() {
  int r;
  asm volatile("v_mbcnt_lo_u32_b32 %0, -1, 0\n\tv_mbcnt_hi_u32_b32 %0, -1, %0" : "=v"(r));
  return r;
}
#define TIDX (wave_s * 64 + lane_id_v())
DI size_t opq_o(size_t o) { asm volatile("" : "+s"(o)); return o; }
DI int crow(int i, int h) { return (i & 3) + 8 * (i >> 2) + 4 * h; }


#define XB_TMO      128
#define XB_XCNT(j)  (256  + 64 * (j))
#define XB_XSUB(j)  (1280 + 64 * (j))
#define XB_XGEN(j)  (2304 + 64 * (j))
#define XB_TOP      3328
#define XB_TOPGEN   3392
#define XCD_BAR_WORDS 3456
#define XB_SPIN_CAP (1u << 18)
#define LAS __attribute__((address_space(3)))
DI unsigned xb_ld(unsigned* p) { return __hip_atomic_load(p, __ATOMIC_RELAXED, __HIP_MEMORY_SCOPE_AGENT); }
DI unsigned xb_add(unsigned* p, unsigned v) { return __hip_atomic_fetch_add(p, v, __ATOMIC_RELAXED, __HIP_MEMORY_SCOPE_AGENT); }
DI unsigned xb_xcc_id() { return (unsigned)__builtin_amdgcn_s_getreg((3 << 11) | 20) & 0xFu; }
#define XB_SPIN(cond, bar) do { unsigned _sp = 0; while (cond) { __builtin_amdgcn_s_sleep(1); \
    if ((++_sp & 255u) == 0u) { if (xb_ld(&(bar)[XB_TMO])) break; if (_sp > XB_SPIN_CAP) { atomicAdd(&(bar)[XB_TMO], 1u); break; } } } } while (0)
struct XcdBarrier { unsigned* bar; unsigned x; volatile LAS unsigned* st; };
DI XcdBarrier xcd_barrier_post(unsigned* bar, volatile LAS unsigned* st, bool is_t0) {
  XcdBarrier b; b.bar = bar; b.x = xb_xcc_id(); b.st = st;
  if (is_t0) (void)xb_add(&bar[XB_XCNT(b.x)], 1u);
  return b;
}
DI void xcd_barrier_complete(unsigned* bar, unsigned x, unsigned& nloc, unsigned& nx) {
  const unsigned G = gridDim.x * gridDim.y * gridDim.z;
  unsigned sum, cnt, mine, sp = 0u;
  for (;;) {
    sum = 0u; cnt = 0u; mine = 0u;
#pragma unroll
    for (unsigned j = 0; j < 16; ++j) { const unsigned c = xb_ld(&bar[XB_XCNT(j)]); sum += c; cnt += (c > 0u) ? 1u : 0u; mine = (j == x) ? c : mine; }
    if (sum == G) break;
    __builtin_amdgcn_s_sleep(1);
    if ((++sp & 255u) == 0u) { if (xb_ld(&bar[XB_TMO])) break; if (sp > XB_SPIN_CAP) { atomicAdd(&bar[XB_TMO], 1u); break; } }
  }
  nloc = mine > 0u ? mine : 1u; nx = cnt > 0u ? cnt : 1u;
}
DI void xcd_barrier(const XcdBarrier& b, bool is_t0) {
  asm volatile("s_waitcnt vmcnt(0)" ::: "memory");
  __syncthreads();
  if (is_t0) {
    unsigned* bar = b.bar;
    __builtin_amdgcn_s_waitcnt(0);
    unsigned nloc = b.st[0], nx = b.st[1];
    if (nloc == 0u) { xcd_barrier_complete(bar, b.x, nloc, nx); b.st[0] = nloc; b.st[1] = nx; }
    const unsigned old = xb_add(&bar[XB_XSUB(b.x)], 1u);
    const unsigned gen = old / nloc;
    if (old + 1u == (gen + 1u) * nloc) {
      __builtin_amdgcn_fence(__ATOMIC_RELEASE, "agent");
      asm volatile("s_waitcnt vmcnt(0)" ::: "memory");
      const unsigned og = xb_add(&bar[XB_TOP], 1u);
      const unsigned tg = og / nx;
      if (og + 1u == (tg + 1u) * nx) xb_add(&bar[XB_TOPGEN], 1u);
      else XB_SPIN(xb_ld(&bar[XB_TOPGEN]) == tg, bar);
      __builtin_amdgcn_fence(__ATOMIC_ACQUIRE, "agent");
      xb_add(&bar[XB_XGEN(b.x)], 1u);
      asm volatile("s_waitcnt vmcnt(0)" ::: "memory");
    } else {
      XB_SPIN(xb_ld(&bar[XB_XGEN(b.x)]) == gen, bar);
      __builtin_amdgcn_fence(__ATOMIC_ACQUIRE, "agent");
      asm volatile("s_waitcnt vmcnt(0)" ::: "memory");
    }
  }
  __syncthreads();
}


constexpr int G_HT = 128 * 64;
DI int lds_byte(int r, int c) {
  int st = (r >> 4) * 2 + (c >> 5), rr = r & 15, cc = c & 31, ob = rr * 64 + cc * 2;
  return st * 1024 + (ob ^ (((ob >> 9) & 1) << 5));
}
DI void stage_rc(int b, int& R, int& C) {
  int st = b / 1024, sb = b % 1024, swz = sb ^ (((sb >> 9) & 1) << 5);
  R = (st >> 1) * 16 + swz / 64;
  C = (st & 1) * 32 + (swz % 64) / 2;
}

template <class Mid>
DI void gemm256(const ushort_t* __restrict__ A, const ushort_t* __restrict__ Bt, f32x4 (&acc)[2][2][4][2],
                unsigned char* shm_, Mid mid, const int wave_s) {
  constexpr int K = 1024, BK = 64, HALF = 128, nt = K / BK;
  ushort_t* shm = (ushort_t*)shm_;
  const int tid = TIDX;
  const int wid = tid >> 6, lane = tid & 63, wr = wid >> 2, wc = wid & 3, fr = lane & 15, fq = lane >> 4;
  unsigned go0, go1;
  {
    int r_, c_;
    stage_rc(tid * 16, r_, c_);
    go0 = (unsigned)(r_ * K + c_) * 2u;
    stage_rc(tid * 16 + 8192, r_, c_);
    go1 = (unsigned)(r_ * K + c_) * 2u;
  }
#define SA(b, h) (shm + ((b) * 2 + (h)) * G_HT)
#define SB(b, h) (shm + (4 + (b) * 2 + (h)) * G_HT)
#define STAGE(P, BASE, br, kt)                                                                                      \
  do {                                                                                                              \
    const char* _g = (const char*)((BASE) + (size_t)(br) * K + (kt) * BK);                                          \
    __builtin_amdgcn_global_load_lds((const unsigned*)(_g + go0), (LAS unsigned*)((char*)(P) + wave_s * 1024), 16, 0, 0); \
    __builtin_amdgcn_global_load_lds((const unsigned*)(_g + go1), (LAS unsigned*)((char*)(P) + wave_s * 1024 + 8192), 16, 0, 0); \
  } while (0)
#define LDA(dst, b, h)                                                                                              \
  _Pragma("unroll") for (int m = 0; m < 4; ++m) _Pragma("unroll") for (int k = 0; k < 2; ++k)                       \
      dst[m][k] = *reinterpret_cast<const bf16x8*>((char*)SA(b, h) + lds_byte(wr * 64 + m * 16 + fr, k * 32 + fq * 8))
#define LDB(dst, b, h)                                                                                              \
  _Pragma("unroll") for (int n = 0; n < 2; ++n) _Pragma("unroll") for (int k = 0; k < 2; ++k)                       \
      dst[n][k] = *reinterpret_cast<const bf16x8*>((char*)SB(b, h) + lds_byte(wc * 32 + n * 16 + fr, k * 32 + fq * 8))
#define MMA(ai, bj, At_, Bt_)                                                                                       \
  do {                                                                                                              \
    __builtin_amdgcn_s_setprio(1);                                                                                  \
    _Pragma("unroll") for (int m = 0; m < 4; ++m) _Pragma("unroll") for (int n = 0; n < 2; ++n)                     \
        _Pragma("unroll") for (int k = 0; k < 2; ++k) acc[ai][bj][m][n] =                                           \
            __builtin_amdgcn_mfma_f32_16x16x32_bf16(At_[m][k], Bt_[n][k], acc[ai][bj][m][n], 0, 0, 0);              \
    __builtin_amdgcn_s_setprio(0);                                                                                  \
  } while (0)
#define WAIT_V(n) asm volatile("s_waitcnt vmcnt(" #n ")" ::: "memory")
#define WAIT_L(n) asm volatile("s_waitcnt lgkmcnt(" #n ")" ::: "memory")
#define BAR __builtin_amdgcn_s_barrier()
#define SCHED __builtin_amdgcn_sched_barrier(0)
  bf16x8 At[4][2], B0[2][2], B1[2][2];
  STAGE(SB(0, 0), Bt, 0, 0); STAGE(SA(0, 0), A, 0, 0);
  STAGE(SB(0, 1), Bt, HALF, 0); STAGE(SA(0, 1), A, HALF, 0);
  if (wr == 1) BAR;
  WAIT_V(4); BAR;
  STAGE(SB(1, 0), Bt, 0, 1); STAGE(SA(1, 0), A, 0, 1); STAGE(SB(1, 1), Bt, HALF, 1);
  WAIT_V(6); BAR;
#pragma unroll 1
  for (int t = 0; t < nt - 2; t += 2) {
    if (t == nt / 2) mid(acc);
    LDB(B0, 0, 0); SCHED; LDA(At, 0, 0); STAGE(SA(1, 1), A, HALF, t + 1);
    WAIT_L(8); BAR; WAIT_L(0); MMA(0, 0, At, B0); BAR; SCHED;
    LDB(B1, 0, 1); STAGE(SB(0, 0), Bt, 0, t + 2);
    BAR; WAIT_L(0); MMA(0, 1, At, B1); BAR;
    LDA(At, 0, 1); STAGE(SA(0, 0), A, 0, t + 2);
    BAR; WAIT_L(0); MMA(1, 0, At, B0); BAR; SCHED;
    STAGE(SB(0, 1), Bt, HALF, t + 2);
    WAIT_V(6); BAR; MMA(1, 1, At, B1); BAR;
    LDB(B0, 1, 0); SCHED; LDA(At, 1, 0); STAGE(SA(0, 1), A, HALF, t + 2);
    WAIT_L(8); BAR; WAIT_L(0); MMA(0, 0, At, B0); BAR; SCHED;
    LDB(B1, 1, 1); STAGE(SB(1, 0), Bt, 0, t + 3);
    BAR; WAIT_L(0); MMA(0, 1, At, B1); BAR;
    LDA(At, 1, 1); STAGE(SA(1, 0), A, 0, t + 3);
    BAR; WAIT_L(0); MMA(1, 0, At, B0); BAR; SCHED;
    STAGE(SB(1, 1), Bt, HALF, t + 3);
    WAIT_V(6); BAR; MMA(1, 1, At, B1); BAR;
  }
  {
    LDB(B0, 0, 0); LDA(At, 0, 0); STAGE(SA(1, 1), A, HALF, nt - 1);
    BAR; WAIT_L(0); MMA(0, 0, At, B0); BAR;
    LDB(B1, 0, 1); BAR; WAIT_L(0); MMA(0, 1, At, B1); BAR;
    LDA(At, 0, 1); WAIT_V(4); BAR; WAIT_L(0); MMA(1, 0, At, B0); MMA(1, 1, At, B1); BAR;
  }
  {
    LDB(B0, 1, 0); LDA(At, 1, 0); WAIT_V(2); BAR; WAIT_L(0); MMA(0, 0, At, B0); BAR;
    LDB(B1, 1, 1); WAIT_V(0); BAR; WAIT_L(0); MMA(0, 1, At, B1); BAR;
    LDA(At, 1, 1); BAR; WAIT_L(0); MMA(1, 0, At, B0); MMA(1, 1, At, B1); BAR;
  }
  if (wr == 0) BAR;
#undef SA
#undef SB
#undef STAGE
#undef LDA
#undef LDB
#undef MMA
}

constexpr int N_TPAIR = 72 + 32 + 8;
DI void weight_pair_item(const Params& p, int L, int it, unsigned char* sm, const int wave_s);
DI void sw_item(const Params& p, int L, int it, unsigned char* sm, const int wave_s);
constexpr int N_SWITEM = 16 * 5;
DI int mod_row(int m0) { return m0 < NCTX ? 0 : 1 + ((m0 - NCTX) >> 11); }


DI void phase_inproj(const Params& p, int l, unsigned char* sm, const int wave_s) {
  const ushort_t* WtIn = (const ushort_t*)(p.ws + opq_o(OFF_WTIN)) + (size_t)l * 2304 * 1024;
  const ushort_t* xg = (const ushort_t*)(p.ws + opq_o(OFF_XG));
  ushort_t* P = (ushort_t*)(p.ws + opq_o(OFF_P));
  const float* rowss = (const float*)(p.ws + opq_o(OFF_ROWSS));
  const float* swpart = (const float*)(p.ws + opq_o(OFF_SWPART));
  const float2* ropecs = (const float2*)(p.ws + opq_o(OFF_ROPE));
  {
    const int tid0 = TIDX;
    ((uint4*)(sm + L_ROPE))[tid0] = ((const uint4*)ropecs)[tid0];
  }
  for (int t = blockIdx.x; t < 9 * 48; t += gridDim.x) {
    const int pn = (t & 7) + 8 * ((t >> 3) % 6), pm = (t >> 3) / 6;
    const int brow = pm * 256, bcol = pn * 256;
    const bool lat = bcol >= NCTX;
    const int bidx = mod_row(bcol);
    f32x4 acc[2][2][4][2];
#pragma unroll
    for (int a = 0; a < 2; ++a)
#pragma unroll
      for (int b = 0; b < 2; ++b)
#pragma unroll
        for (int m = 0; m < 4; ++m)
#pragma unroll
          for (int n = 0; n < 2; ++n) acc[a][b][m][n] = (f32x4){0.f, 0.f, 0.f, 0.f};
    __syncthreads();
    {
      const int tid1 = TIDX;
      if (tid1 < 256) {
        const float* sp_ = swpart + (size_t)(l * 5 + bidx) * 2304 + brow + tid1;
        float s = 0.f;
#pragma unroll
        for (int kc = 0; kc < 16; ++kc) s += sp_[(size_t)kc * 46080];
        ((float*)(sm + L_SW))[tid1] = s;
      } else {
        const int tl = tid1 - 256;
        const float4* rs = (const float4*)(rowss + (size_t)(bcol + tl) * 8);
        const float4 s0 = rs[0], s1 = rs[1];
        const float ss = ((s0.x + s0.y) + (s0.z + s0.w)) + ((s1.x + s1.y) + (s1.z + s1.w));
        ((float*)(sm + L_RR))[tl] = rsqrtf(ss * (1.f / 1024.f) + EPS);
      }
    }
    gemm256(WtIn + (size_t)brow * 1024, xg + (size_t)bcol * 1024, acc, sm, [](f32x4(&)[2][2][4][2]) {}, wave_s);
    const int tid2 = TIDX, wid2 = tid2 >> 6, lane2 = tid2 & 63;
    const int wr = wid2 >> 2, wc = wid2 & 3, fr = lane2 & 15, fq = lane2 >> 4;
    const float* swt = (const float*)(sm + L_SW);
    const float* rrt = (const float*)(sm + L_RR);
    const float2* ropeL = (const float2*)(sm + L_ROPE);
#pragma unroll
    for (int bj = 0; bj < 2; ++bj)
#pragma unroll
      for (int n = 0; n < 2; ++n) {
        const int tloc = bj * 128 + wc * 32 + n * 16 + fr;
        const int tk = bcol + tloc;
        const float rr = rrt[tloc];
        const int tpos = (tk - NCTX) & 2047;
#pragma unroll
        for (int ai = 0; ai < 2; ++ai) {
          const int floc = ai * 128 + wr * 64;
          const int f0 = brow + floc;
          float v[4][4];
#pragma unroll
          for (int m = 0; m < 4; ++m) {
            const float4 sv = *(const float4*)(swt + floc + m * 16 + fq * 4);
            v[m][0] = acc[ai][bj][m][n][0] * rr + sv.x;
            v[m][1] = acc[ai][bj][m][n][1] * rr + sv.y;
            v[m][2] = acc[ai][bj][m][n][2] * rr + sv.z;
            v[m][3] = acc[ai][bj][m][n][3] * rr + sv.w;
          }
          if (lat && f0 < 640) {
#pragma unroll
            for (int hlf = 0; hlf < 2; ++hlf) {
              const int pos = hlf == 0 ? (tpos >> 6) : (tpos & 63);
              const float4* cp = (const float4*)(ropeL + pos * 16 + fq * 4);
              const float4 c01 = cp[0], c23 = cp[1];
              const float cs_[4] = {c01.x, c01.z, c23.x, c23.z};
              const float sn_[4] = {c01.y, c01.w, c23.y, c23.w};
#pragma unroll
              for (int e = 0; e < 4; ++e) {
                const float x1 = v[2 * hlf][e], x2 = v[2 * hlf + 1][e];
                v[2 * hlf][e] = x1 * cs_[e] - x2 * sn_[e];
                v[2 * hlf + 1][e] = x2 * cs_[e] + x1 * sn_[e];
              }
            }
          }
          const float qs = f0 < 512 ? 0.125f * LOG2E : 1.f;
#pragma unroll
          for (int m = 0; m < 4; ++m) {
            uint2 o;
            o.x = pack2(v[m][0] * qs, v[m][1] * qs);
            o.y = pack2(v[m][2] * qs, v[m][3] * qs);
            *(uint2*)(P + (size_t)tk * INW + f0 + m * 16 + fq * 4) = o;
          }
          const int f128 = f0 >> 7;
          if (!lat && (f128 == 4 || f128 == 5)) {
            const int b = tk >> 8, s = tk & 255;
            float* dst = p.out + (size_t)12582912 + (f128 == 5 ? (size_t)2097152 : 0) +
                         ((size_t)((b * 4 + l) * 256 + s)) * 128 + (f0 & 127);
#pragma unroll
            for (int m = 0; m < 4; ++m)
              *(float4*)(dst + m * 16 + fq * 4) = make_float4(v[m][0], v[m][1], v[m][2], v[m][3]);
          }
        }
      }
  }
}

DI void phase_outproj(const Params& p, int l, unsigned char* sm, const int wave_s) {
  const ushort_t* WtOut = (const ushort_t*)(p.ws + opq_o(OFF_WTOUT)) + (size_t)l * 1024 * 1024;
  const ushort_t* am = (const ushort_t*)(p.ws + opq_o(OFF_AM));
  ushort_t* xg = (ushort_t*)(p.ws + opq_o(OFF_XG));
  float* xws = (float*)(p.ws + opq_o(OFF_X));
  const float* xprev = xws;
  float* rowss = (float*)(p.ws + opq_o(OFF_ROWSS));
  const float* ssa = (const float*)(p.ws + opq_o(OFF_SSA));
  const float* ssp = (const float*)(p.ws + opq_o(OFF_SSP));
  const float* mod = (const float*)(p.ws + opq_o(OFF_MOD));
  for (int t = blockIdx.x; t < 4 * 48; t += gridDim.x) {
    const int pn = (t & 7) + 8 * ((t >> 3) >> 2), pm = (t >> 3) & 3;
    const int brow = pm * 256, bcol = pn * 256;
    const int bidx = mod_row(bcol);
    f32x4 acc[2][2][4][2];
#pragma unroll
    for (int a = 0; a < 2; ++a)
#pragma unroll
      for (int b = 0; b < 2; ++b)
#pragma unroll
        for (int m = 0; m < 4; ++m)
#pragma unroll
          for (int n = 0; n < 2; ++n) acc[a][b][m][n] = (f32x4){0.f, 0.f, 0.f, 0.f};
    __syncthreads();
    {
      const int tid1 = TIDX;
      if (tid1 < 256) {
        const int tk = bcol + tid1;
        const float4* pa = (const float4*)(ssa + (size_t)tk * 8);
        const float4* pp = (const float4*)(ssp + (size_t)tk * 8);
        const float4 a0 = pa[0], a1 = pa[1], b0 = pp[0], b1 = pp[1];
        const float sa_ = ((a0.x + a0.y) + (a0.z + a0.w)) + ((a1.x + a1.y) + (a1.z + a1.w));
        const float sp_ = ((b0.x + b0.y) + (b0.z + b0.w)) + ((b1.x + b1.y) + (b1.z + b1.w));
        const float ra = rsqrtf(sa_ * (1.f / 512.f) + EPS), rpv = rsqrtf(sp_ * (1.f / 512.f) + EPS);
        ((float*)(sm + L_RATIO))[tid1] = ra / rpv;
        ((float*)(sm + L_RP))[tid1] = rpv;
      } else {
        const int f = brow + tid1 - 256;
        const float gt = mod[(size_t)(l * 5 + bidx) * 3072 + 2048 + f];
        float gn = 0.f;
        if (l < 3) gn = p.norm_w[(size_t)(l + 1) * 1024 + f] * (1.f + mod[(size_t)((l + 1) * 5 + bidx) * 3072 + 1024 + f]);
        ((float2*)(sm + L_GG))[tid1 - 256] = make_float2(gt, gn);
      }
    }
    gemm256(WtOut + (size_t)brow * 1024, am + (size_t)bcol * 1024, acc, sm, [&](f32x4(&ac)[2][2][4][2]) {
      const int tidm = TIDX;
      const float* rt = (const float*)(sm + L_RATIO) + ((tidm >> 6) & 3) * 32 + (tidm & 15);
#pragma unroll
      for (int b = 0; b < 2; ++b)
#pragma unroll
        for (int n = 0; n < 2; ++n) {
          const float rv = rt[b * 128 + n * 16];
#pragma unroll
          for (int a = 0; a < 2; ++a)
#pragma unroll
            for (int m = 0; m < 4; ++m) ac[a][b][m][n] *= rv;
          __builtin_amdgcn_sched_barrier(0);
        }
    }, wave_s);
    const int tid2 = TIDX, wid2 = tid2 >> 6, lane2 = tid2 & 63;
    const int wr = wid2 >> 2, wc = wid2 & 3, fr = lane2 & 15, fq = lane2 >> 4;
    const int tk0 = bcol + wc * 32 + fr;
    const float* xsrc0 = (l == 0) ? (tk0 < NCTX ? p.x_prompt + (size_t)tk0 * 1024 : p.x_sample + (size_t)(tk0 - NCTX) * 1024)
                                  : xprev + (size_t)tk0 * 1024;
    const float* rpt = (const float*)(sm + L_RP) + wc * 32 + fr;
    const float rp[2][2] = {{rpt[0], rpt[16]}, {rpt[128], rpt[144]}};
    const float4* ggt = (const float4*)(sm + L_GG);
    float ssq[2][2] = {{0.f, 0.f}, {0.f, 0.f}};
#pragma unroll
    for (int ai = 0; ai < 2; ++ai) {
      float4 xv[4][2][2];
#pragma unroll
      for (int m = 0; m < 4; ++m)
#pragma unroll
        for (int bj = 0; bj < 2; ++bj)
#pragma unroll
          for (int n = 0; n < 2; ++n)
            xv[m][bj][n] = *(const float4*)(xsrc0 + (size_t)(bj * 128 + n * 16) * 1024 + brow + ai * 128 + wr * 64 + m * 16 + fq * 4);
#pragma unroll
      for (int m = 0; m < 4; ++m) {
        const int floc = ai * 128 + wr * 64 + m * 16 + fq * 4;
        const int f = brow + floc;
        const float4 g01 = ggt[(floc >> 1)], g23 = ggt[(floc >> 1) + 1];
#pragma unroll
        for (int bj = 0; bj < 2; ++bj)
#pragma unroll
          for (int n = 0; n < 2; ++n) {
            const int toff = bj * 128 + n * 16;
            const float rpv = rp[bj][n];
            const float4 x4 = xv[m][bj][n];
            float4 xn;
            xn.x = x4.x + g01.x * (acc[ai][bj][m][n][0] * rpv);
            xn.y = x4.y + g01.z * (acc[ai][bj][m][n][1] * rpv);
            xn.z = x4.z + g23.x * (acc[ai][bj][m][n][2] * rpv);
            xn.w = x4.w + g23.z * (acc[ai][bj][m][n][3] * rpv);
            ssq[bj][n] += (xn.x * xn.x + xn.y * xn.y) + (xn.z * xn.z + xn.w * xn.w);
            *(float4*)(xws + (size_t)(tk0 + toff) * 1024 + f) = xn;
            if (l < 3) {
              uint2 o;
              o.x = pack2(xn.x * g01.y, xn.y * g01.w);
              o.y = pack2(xn.z * g23.y, xn.w * g23.w);
              *(uint2*)(xg + (size_t)(tk0 + toff) * 1024 + f) = o;
            }
          }
      }
      __builtin_amdgcn_sched_barrier(0);
    }
#pragma unroll
    for (int bj = 0; bj < 2; ++bj)
#pragma unroll
      for (int n = 0; n < 2; ++n) {
        float s = ssq[bj][n];
        s += __shfl_xor(s, 16);
        s += __shfl_xor(s, 32);
        if (fq == 0) rowss[(size_t)(tk0 + bj * 128 + n * 16) * 8 + pm * 2 + wr] = s;
      }
  }
}

constexpr int AT_KS_BYTES = 320 * 144;
constexpr int AT_VT_STRIDE = 648;
DI void attn_tiles(const unsigned char* Ks, const unsigned char* Vt, int ntile, bool masked, int kbase, int qpos,
                   const bf16x8 (&qf)[4], float& m_run, float& l_run, f32x16 (&o)[2], int r, int h) {
  const int qa = qpos - r;
#pragma unroll 1
  for (int t = 0; t < ntile; ++t) {
    f32x16 s[2];
#pragma unroll
    for (int kt = 0; kt < 2; ++kt) {
#pragma unroll
      for (int i = 0; i < 16; ++i) s[kt][i] = 0.f;
      const unsigned char* kb = Ks + (t * 64 + kt * 32 + r) * 144 + h * 16;
#pragma unroll
      for (int ks = 0; ks < 4; ++ks) {
        const bf16x8 a = *(const bf16x8*)(kb + ks * 32);
        s[kt] = MFMA32(a, qf[ks], s[kt]);
      }
    }
    float mx = -3.0e38f;
    const int kb = kbase + t * 64;
    if (masked && (kb < qa - 97 || kb > qa + 65)) {
#pragma unroll
      for (int kt = 0; kt < 2; ++kt)
#pragma unroll
        for (int i = 0; i < 16; ++i) {
          const int d = qpos - (kb + kt * 32 + crow(i, h));
          float tv = s[kt][i];
          tv = (d > 128 || d < -128) ? -1.0e30f : tv;
          s[kt][i] = tv;
          mx = fmaxf(mx, tv);
        }
    } else {
#pragma unroll
      for (int kt = 0; kt < 2; ++kt)
#pragma unroll
        for (int i = 0; i < 16; ++i) mx = fmaxf(mx, s[kt][i]);
    }
    mx = fmaxf(mx, __shfl_xor(mx, 32));
    const float m_new = fmaxf(m_run, mx);
    const float alpha = __builtin_amdgcn_exp2f(m_run - m_new);
    m_run = m_new;
    f2_t ps2 = {0.f, 0.f};
    const f2_t mm2 = {m_new, m_new};
#pragma unroll
    for (int kt = 0; kt < 2; ++kt)
#pragma unroll
      for (int i = 0; i < 16; i += 2) {
        f2_t v2 = {s[kt][i], s[kt][i + 1]};
        v2 = v2 - mm2;
        f2_t e2 = {__builtin_amdgcn_exp2f(v2.x), __builtin_amdgcn_exp2f(v2.y)};
        s[kt][i] = e2.x;
        s[kt][i + 1] = e2.y;
        ps2 = ps2 + e2;
      }
    const float psum = ps2.x + ps2.y;
    l_run = l_run * alpha + psum;
#pragma unroll
    for (int i = 0; i < 16; ++i) { o[0][i] *= alpha; o[1][i] *= alpha; }
    bf16x8 pf[4];
#pragma unroll
    for (int st = 0; st < 4; ++st) {
      const int kt = st >> 1, s8 = (st & 1) * 8;
      uint4 u;
      u.x = pack2(s[kt][s8 + 0], s[kt][s8 + 1]);
      u.y = pack2(s[kt][s8 + 2], s[kt][s8 + 3]);
      u.z = pack2(s[kt][s8 + 4], s[kt][s8 + 5]);
      u.w = pack2(s[kt][s8 + 6], s[kt][s8 + 7]);
      pf[st] = __builtin_bit_cast(bf16x8, u);
    }
    const unsigned char* vb = Vt + r * AT_VT_STRIDE + (t * 64) * 2 + h * 8;
#pragma unroll
    for (int dt = 0; dt < 2; ++dt)
#pragma unroll
      for (int st = 0; st < 4; ++st) {
        const s16x4 lo = *(const s16x4*)(vb + dt * 32 * AT_VT_STRIDE + st * 32);
        const s16x4 hi = *(const s16x4*)(vb + dt * 32 * AT_VT_STRIDE + st * 32 + 16);
        const bf16x8 a = __builtin_shufflevector(lo, hi, 0, 1, 2, 3, 4, 5, 6, 7);
        o[dt] = MFMA32(a, pf[st], o[dt]);
      }
  }
}

DI void vt_store(unsigned char* Vt, int key, int ch, const uint4& vr) {
  ushort_t* vt = (ushort_t*)(Vt + (ch * 8) * AT_VT_STRIDE) + key;
  constexpr int S = AT_VT_STRIDE / 2;
  vt[0 * S] = (ushort_t)(vr.x & 0xffff);
  vt[1 * S] = (ushort_t)(vr.x >> 16);
  vt[2 * S] = (ushort_t)(vr.y & 0xffff);
  vt[3 * S] = (ushort_t)(vr.y >> 16);
  vt[4 * S] = (ushort_t)(vr.z & 0xffff);
  vt[5 * S] = (ushort_t)(vr.z >> 16);
  vt[6 * S] = (ushort_t)(vr.w & 0xffff);
  vt[7 * S] = (ushort_t)(vr.w >> 16);
}

DI void attn_item(const Params& p, int l, int item, unsigned char* sm, const int wave_s) {
  const ushort_t* P = (const ushort_t*)(p.ws + opq_o(OFF_P));
  ushort_t* am = (ushort_t*)(p.ws + opq_o(OFF_AM));
  float* ssa = (float*)(p.ws + opq_o(OFF_SSA));
  const int tid = TIDX, wave = tid >> 6, lane = tid & 63, r = lane & 31, h = lane >> 5;
  int b, kvh, q0, tokbase, klo, nkb;
  bool lat;
  if (item < 256) {
    lat = true;
    b = item >> 6;
    kvh = (item >> 5) & 1;
    q0 = (item & 31) * 64;
    tokbase = NCTX + b * 2048;
    klo = q0 - 128 < 0 ? 0 : q0 - 128;
    const int khi = q0 + 192 > 2048 ? 2048 : q0 + 192;
    nkb = khi - klo;
  } else {
    const int it = item - 256;
    lat = false;
    b = it >> 3;
    kvh = (it >> 2) & 1;
    q0 = (it & 3) * 64;
    tokbase = b * 256;
    klo = 0;
    nkb = 256;
  }
  const int hq = kvh * 4 + (wave & 3);
  const int qloc = q0 + (wave >> 2) * 32 + r;
  unsigned char* Ks = sm;
  unsigned char* Vt = sm + AT_KS_BYTES;
  {
    const int nch = nkb * 8;
    uint4 kr[5], vr[5];
#pragma unroll
    for (int i = 0; i < 5; ++i) {
      const int c = tid + i * 512;
      const int cc = c < nch ? c : nch - 1;
      const size_t tok = (size_t)(tokbase + klo + (cc >> 3));
      kr[i] = *(const uint4*)(P + tok * INW + 512 + kvh * 64 + (cc & 7) * 8);
      vr[i] = *(const uint4*)(P + tok * INW + 640 + kvh * 64 + (cc & 7) * 8);
    }
#pragma unroll
    for (int i = 0; i < 5; ++i) {
      const int c = tid + i * 512;
      if (c < nch) {
        *(uint4*)(Ks + (c >> 3) * 144 + (c & 7) * 16) = kr[i];
        vt_store(Vt, c >> 3, c & 7, vr[i]);
      }
    }
  }
  bf16x8 qf[4];
  {
    const ushort_t* qp = P + (size_t)(tokbase + qloc) * INW + hq * 64 + h * 8;
#pragma unroll
    for (int ks = 0; ks < 4; ++ks) qf[ks] = *(const bf16x8*)(qp + ks * 16);
  }
  uint2 gav[2][4];
  float4 anw[2][4];
  {
    const ushort_t* gp_ = P + (size_t)(tokbase + qloc) * INW + 768 + hq * 64 + 4 * h;
#pragma unroll
    for (int dt = 0; dt < 2; ++dt)
#pragma unroll
      for (int g = 0; g < 4; ++g) {
        gav[dt][g] = *(const uint2*)(gp_ + dt * 32 + 8 * g);
        anw[dt][g] = *(const float4*)(p.attn_norm + l * 512 + hq * 64 + dt * 32 + 8 * g + 4 * h);
      }
  }
  float m_run = p.sink[l * 8 + hq] * LOG2E;
  float l_run = (h == 0) ? 1.f : 0.f;
  f32x16 o[2];
#pragma unroll
  for (int i = 0; i < 16; ++i) { o[0][i] = 0.f; o[1][i] = 0.f; }
  uint4 ck[4], cv[4];
#pragma unroll
  for (int i = 0; i < 4; ++i) { ck[i] = make_uint4(0, 0, 0, 0); cv[i] = make_uint4(0, 0, 0, 0); }
  if (lat) {
    const size_t base = (size_t)((b * 4 + l) * 256);
#pragma unroll
    for (int i = 0; i < 4; ++i) {
      const int c = tid + i * 512;
      const int key = c >> 3, ch = c & 7;
      const float4* kp = (const float4*)(p.cache_k + (base + key) * 128 + kvh * 64 + ch * 8);
      const float4* vp = (const float4*)(p.cache_v + (base + key) * 128 + kvh * 64 + ch * 8);
      const float4 k0 = kp[0], k1 = kp[1], v0 = vp[0], v1 = vp[1];
      ck[i] = make_uint4(pack2(k0.x, k0.y), pack2(k0.z, k0.w), pack2(k1.x, k1.y), pack2(k1.z, k1.w));
      cv[i] = make_uint4(pack2(v0.x, v0.y), pack2(v0.z, v0.w), pack2(v1.x, v1.y), pack2(v1.z, v1.w));
    }
  }
  __syncthreads();
  attn_tiles(Ks, Vt, nkb >> 6, lat, klo, qloc, qf, m_run, l_run, o, r, h);
  if (lat) {
    __syncthreads();
#pragma unroll
    for (int i = 0; i < 4; ++i) {
      const int c = tid + i * 512;
      const int key = c >> 3, ch = c & 7;
      *(uint4*)(Ks + key * 144 + ch * 16) = ck[i];
      vt_store(Vt, key, ch, cv[i]);
    }
    __syncthreads();
    attn_tiles(Ks, Vt, 4, false, 0, qloc, qf, m_run, l_run, o, r, h);
  }
  const float l_tot = l_run + __shfl_xor(l_run, 32);
  const float inv = 1.f / l_tot;
  const size_t m = (size_t)(tokbase + qloc);
  const float* an = p.attn_norm + l * 512 + hq * 64;
  float ssq = 0.f;
#pragma unroll
  for (int dt = 0; dt < 2; ++dt)
#pragma unroll
    for (int g = 0; g < 4; ++g) {
      const int d = dt * 32 + 8 * g + 4 * h;
      const uint2 gavv = gav[dt][g];
      const float4 w4 = anw[dt][g];
      const float o0 = o[dt][4 * g + 0] * inv, o1 = o[dt][4 * g + 1] * inv, o2 = o[dt][4 * g + 2] * inv,
                  o3 = o[dt][4 * g + 3] * inv;
      ssq += (o0 * o0 + o1 * o1) + (o2 * o2 + o3 * o3);
      uint2 ov;
      ov.x = pack2(o0 * w4.x * silu_f(bflo(gavv.x)), o1 * w4.y * silu_f(bfhi(gavv.x)));
      ov.y = pack2(o2 * w4.z * silu_f(bflo(gavv.y)), o3 * w4.w * silu_f(bfhi(gavv.y)));
      *(uint2*)(am + m * 1024 + hq * 64 + d) = ov;
    }
  ssq += __shfl_xor(ssq, 32);
  if (h == 0) ssa[m * 8 + hq] = ssq;
}

template <int HALF>
DI void pool_window(const unsigned char* U, unsigned char* Pm, int t0, int L, int tid) {
  const int cp = tid & 63, seg = tid >> 6;
  const int tl0 = seg * 16;
  const unsigned char* up = U + (tl0 + 8 - HALF) * 272 + cp * 4;
  float s0 = 0.f, s1 = 0.f;
#pragma unroll
  for (int j = 0; j < 2 * HALF; ++j) {
    const unsigned u = *(const unsigned*)(up + j * 272);
    s0 += bflo(u);
    s1 += bfhi(u);
  }
#pragma unroll
  for (int i = 0; i < 16; ++i) {
    const int tl = tl0 + i;
    const int t = t0 + tl;
    const int lo = t - HALF < 0 ? 0 : t - HALF;
    const int hi = t + HALF > L ? L : t + HALF;
    const unsigned xc = *(const unsigned*)(U + (tl + 8) * 272 + cp * 4);
    const float invc = 1.f / (float)(hi - lo);
    *(unsigned*)(Pm + tl * 272 + cp * 4) = pack2(s0 * invc - bflo(xc), s1 * invc - bfhi(xc));
    if (i < 15) {
      const unsigned ua = *(const unsigned*)(up + (i + 2 * HALF) * 272);
      const unsigned ub = *(const unsigned*)(up + i * 272);
      s0 += bflo(ua) - bflo(ub);
      s1 += bfhi(ua) - bfhi(ub);
    }
  }
}

DI void pool_item(const Params& p, int l, int item, unsigned char* sm, const int wave_s) {
  const ushort_t* P = (const ushort_t*)(p.ws + opq_o(OFF_P));
  ushort_t* am = (ushort_t*)(p.ws + opq_o(OFF_AM));
  float* ssp = (float*)(p.ws + opq_o(OFF_SSP));
  const ushort_t* Wp = (const ushort_t*)(p.ws + opq_o(OFF_WTPOOL));
  const int tid = TIDX, wave = tid >> 6, lane = tid & 63, r = lane & 31, h = lane >> 5;
  const int tt = item >> 2, g = item & 3;
  const int m0 = tt * 128;
  int L, sbase;
  if (m0 < NCTX) { L = 256; sbase = m0 & ~255; } else { L = 2048; sbase = NCTX + ((m0 - NCTX) & ~2047); }
  const int t0 = m0 - sbase;
  unsigned char* U = sm;
  unsigned char* W = sm + 39168;
  unsigned char* Pm = sm + 39168 + 34816;
  const ushort_t* wsrc = Wp + (size_t)(l * 4 + g) * 128 * 128;
  {
    uint4 uu[5], ww[4];
#pragma unroll
    for (int i = 0; i < 5; ++i) {
      const int c = tid + i * 512;
      const int row = c >> 4, ch = c & 15;
      const int pos = t0 - 8 + row;
      uu[i] = make_uint4(0, 0, 0, 0);
      if (c < 144 * 16 && pos >= 0 && pos < L) uu[i] = *(const uint4*)(P + (size_t)(sbase + pos) * INW + 1280 + g * 128 + ch * 8);
    }
#pragma unroll
    for (int i = 0; i < 4; ++i) {
      const int c = tid + i * 512;
      ww[i] = *(const uint4*)(wsrc + (c >> 4) * 128 + (c & 15) * 8);
    }
#pragma unroll
    for (int i = 0; i < 5; ++i) {
      const int c = tid + i * 512;
      if (c < 144 * 16) *(uint4*)(U + (c >> 4) * 272 + (c & 15) * 16) = uu[i];
    }
#pragma unroll
    for (int i = 0; i < 4; ++i) {
      const int c = tid + i * 512;
      *(uint4*)(W + (c >> 4) * 272 + (c & 15) * 16) = ww[i];
    }
  }
  const int wm = wave & 3, wn = wave >> 2;
  const size_t m = (size_t)(m0 + wm * 32 + r);
  uint2 gpv_[2][4];
  float4 ps_[2][4], pn_[2][4];
#pragma unroll
  for (int nt = 0; nt < 2; ++nt)
#pragma unroll
    for (int gq = 0; gq < 4; ++gq)
    {
      const int c_ = g * 128 + wn * 64 + nt * 32 + 8 * gq + 4 * h;
      gpv_[nt][gq] = *(const uint2*)(P + m * INW + 1792 + c_);
      ps_[nt][gq] = *(const float4*)(p.pool_scale + l * 512 + c_);
      pn_[nt][gq] = *(const float4*)(p.pool_norm + l * 512 + c_);
    }
  __syncthreads();
  switch (g) {
    case 0: pool_window<1>(U, Pm, t0, L, tid); break;
    case 1: pool_window<2>(U, Pm, t0, L, tid); break;
    case 2: pool_window<4>(U, Pm, t0, L, tid); break;
    default: pool_window<8>(U, Pm, t0, L, tid); break;
  }
  __syncthreads();
  f32x16 acc[2];
#pragma unroll
  for (int i = 0; i < 16; ++i) { acc[0][i] = 0.f; acc[1][i] = 0.f; }
  const unsigned char* wa = W + (wn * 64 + r) * 272 + h * 16;
  const unsigned char* pb = Pm + (wm * 32 + r) * 272 + h * 16;
#pragma unroll
  for (int ks = 0; ks < 8; ++ks) {
    const bf16x8 bq = *(const bf16x8*)(pb + ks * 32);
    const bf16x8 a0 = *(const bf16x8*)(wa + ks * 32);
    const bf16x8 a1 = *(const bf16x8*)(wa + 32 * 272 + ks * 32);
    acc[0] = MFMA32(a0, bq, acc[0]);
    acc[1] = MFMA32(a1, bq, acc[1]);
  }
  float ssq = 0.f;
#pragma unroll
  for (int nt = 0; nt < 2; ++nt)
#pragma unroll
    for (int gq = 0; gq < 4; ++gq) {
      const int c = g * 128 + wn * 64 + nt * 32 + 8 * gq + 4 * h;
      const float4 ps = ps_[nt][gq];
      const float4 pn = pn_[nt][gq];
      const uint2 gpv = gpv_[nt][gq];
      const float o0 = acc[nt][4 * gq + 0] * ps.x, o1 = acc[nt][4 * gq + 1] * ps.y, o2 = acc[nt][4 * gq + 2] * ps.z,
                  o3 = acc[nt][4 * gq + 3] * ps.w;
      ssq += (o0 * o0 + o1 * o1) + (o2 * o2 + o3 * o3);
      uint2 ov;
      ov.x = pack2(o0 * pn.x * silu_f(bflo(gpv.x)), o1 * pn.y * silu_f(bfhi(gpv.x)));
      ov.y = pack2(o2 * pn.z * silu_f(bflo(gpv.y)), o3 * pn.w * silu_f(bfhi(gpv.y)));
      *(uint2*)(am + m * 1024 + 512 + c) = ov;
    }
  ssq += __shfl_xor(ssq, 32);
  if (h == 0) ssp[m * 8 + g * 2 + wn] = ssq;
}

DI void transpose_item(const float* __restrict__ src, ushort_t* __restrict__ dst, int R, int C, int r0, int c0,
                       unsigned char* sm, int t256) {
  float* T = (float*)sm;
  const int rr = t256 >> 4, cc4 = (t256 & 15) * 4;
#pragma unroll
  for (int i = 0; i < 4; ++i) {
    const int row = rr + 16 * i;
    const float4 v = *(const float4*)(src + (size_t)(r0 + row) * C + c0 + cc4);
    T[row * 65 + cc4 + 0] = v.x;
    T[row * 65 + cc4 + 1] = v.y;
    T[row * 65 + cc4 + 2] = v.z;
    T[row * 65 + cc4 + 3] = v.w;
  }
  __syncthreads();
  const int c = t256 >> 2, rseg = (t256 & 3) * 16;
  uint4 o0, o1;
  o0.x = pack2(T[(rseg + 0) * 65 + c], T[(rseg + 1) * 65 + c]);
  o0.y = pack2(T[(rseg + 2) * 65 + c], T[(rseg + 3) * 65 + c]);
  o0.z = pack2(T[(rseg + 4) * 65 + c], T[(rseg + 5) * 65 + c]);
  o0.w = pack2(T[(rseg + 6) * 65 + c], T[(rseg + 7) * 65 + c]);
  o1.x = pack2(T[(rseg + 8) * 65 + c], T[(rseg + 9) * 65 + c]);
  o1.y = pack2(T[(rseg + 10) * 65 + c], T[(rseg + 11) * 65 + c]);
  o1.z = pack2(T[(rseg + 12) * 65 + c], T[(rseg + 13) * 65 + c]);
  o1.w = pack2(T[(rseg + 14) * 65 + c], T[(rseg + 15) * 65 + c]);
  ushort_t* d = dst + (size_t)(c0 + c) * R + r0 + rseg;
  *(uint4*)d = o0;
  *(uint4*)(d + 8) = o1;
}


DI void transpose_strip(const float* __restrict__ src, ushort_t* __restrict__ dst, int R, int C, int r0, int c0,
                        unsigned char* sm, int t256) {
  float* T = (float*)sm;
  const int rr = t256 >> 6, cc4 = (t256 & 63) * 4;
  float4 v[16];
#pragma unroll
  for (int i = 0; i < 16; ++i) v[i] = *(const float4*)(src + (size_t)(r0 + rr + 4 * i) * C + c0 + cc4);
#pragma unroll
  for (int i = 0; i < 16; ++i) {
    float* t = T + (rr + 4 * i) * 257 + cc4;
    t[0] = v[i].x; t[1] = v[i].y; t[2] = v[i].z; t[3] = v[i].w;
  }
  __syncthreads();
  ushort_t* d = dst + (size_t)(c0 + t256) * R + r0;
#pragma unroll
  for (int g = 0; g < 8; ++g) {
    uint4 o;
    o.x = pack2(T[(8 * g + 0) * 257 + t256], T[(8 * g + 1) * 257 + t256]);
    o.y = pack2(T[(8 * g + 2) * 257 + t256], T[(8 * g + 3) * 257 + t256]);
    o.z = pack2(T[(8 * g + 4) * 257 + t256], T[(8 * g + 5) * 257 + t256]);
    o.w = pack2(T[(8 * g + 6) * 257 + t256], T[(8 * g + 7) * 257 + t256]);
    *(uint4*)(d + 8 * g) = o;
  }
}

DI void weight_pair_item(const Params& p, int L, int it, unsigned char* sm, const int wave_s) {
  const int tid = TIDX;
  const int half = tid >> 8, t256 = tid & 255;
  if (it < 72) {
    const int it2 = it * 2 + half;
    const int rt = it2 / 9, ct = it2 % 9;
    transpose_strip(p.w_in + (size_t)L * 1024 * 2304, (ushort_t*)(p.ws + OFF_WTIN) + (size_t)L * 2304 * 1024, 1024, 2304,
                    rt * 64, ct * 256, sm + half * 65792, t256);
  } else if (it < 72 + 32) {
    const int it2 = (it - 72) * 2 + half;
    const int rt = it2 >> 2, ct = it2 & 3;
    transpose_strip(p.w_out + (size_t)L * 1024 * 1024, (ushort_t*)(p.ws + OFF_WTOUT) + (size_t)L * 1024 * 1024, 1024, 1024,
                    rt * 64, ct * 256, sm + half * 65792, t256);
  } else {
    const int it2 = (it - 72 - 32) * 2 + half;
    const int mat = L * 4 + (it2 >> 2), rt = (it2 >> 1) & 1, ct = it2 & 1;
    transpose_item(p.w_pool + (size_t)mat * 128 * 128, (ushort_t*)(p.ws + OFF_WTPOOL) + (size_t)mat * 128 * 128, 128, 128,
                   rt * 64, ct * 64, sm + half * 16640, t256);
  }
}

DI void mod_item(const Params& p, int L, int cg64, unsigned char* sm, const int wave_s) {
  const int tid = TIDX, wave = tid >> 6, lane = tid & 63;
  float* sv = (float*)sm;
  float* red = (float*)(sm + 20480);
  for (int idx = tid; idx < 5120; idx += 512) {
    const int rr = idx >> 10, k = idx & 1023;
    const float cv = rr == 0 ? p.c_ctx[k] : p.c[(rr - 1) * 1024 + k];
    sv[idx] = silu_f(cv);
  }
  __syncthreads();
  const int j = cg64 * 64 + lane;
  const float* wp = p.w_ada + ((size_t)L * 1024 + wave * 128) * 3072 + j;
  const float* s0 = sv + wave * 128;
  float a0 = 0.f, a1 = 0.f, a2 = 0.f, a3 = 0.f, a4 = 0.f;
#pragma unroll 8
  for (int kk = 0; kk < 128; ++kk) {
    const float w = wp[(size_t)kk * 3072];
    a0 += s0[kk] * w;
    a1 += s0[1024 + kk] * w;
    a2 += s0[2048 + kk] * w;
    a3 += s0[3072 + kk] * w;
    a4 += s0[4096 + kk] * w;
  }
  float* rd = red + (wave * 5) * 64 + lane;
  rd[0] = a0; rd[64] = a1; rd[128] = a2; rd[192] = a3; rd[256] = a4;
  __syncthreads();
  if (tid < 320) {
    const int rr = tid >> 6, c = tid & 63;
    float s = p.b_ada[L * 3072 + cg64 * 64 + c];
#pragma unroll
    for (int w = 0; w < 8; ++w) s += red[(w * 5 + rr) * 64 + c];
    ((float*)(p.ws + OFF_MOD))[(size_t)(L * 5 + rr) * 3072 + cg64 * 64 + c] = s;
  }
}

DI void sw_item(const Params& p, int L, int it, unsigned char* sm, const int wave_s) {
  const int tid = TIDX, half = tid >> 8, t256 = tid & 255;
  const int kc = it / 5, cgp = (it % 5) * 2 + half;
  const float* mod = (const float*)(p.ws + OFF_MOD);
  float* sh = (float*)sm + half * 320;
  for (int idx = t256; idx < 320; idx += 256) {
    const int rr = idx >> 6, kk = idx & 63;
    sh[idx] = mod[(size_t)(L * 5 + rr) * 3072 + kc * 64 + kk];
  }
  __syncthreads();
  if (cgp < 9) {
    const int n = cgp * 256 + t256;
    float a0 = 0.f, a1 = 0.f, a2 = 0.f, a3 = 0.f, a4 = 0.f;
    const float* wp = p.w_in + ((size_t)L * 1024 + kc * 64) * 2304 + n;
#pragma unroll 8
    for (int kk = 0; kk < 64; ++kk) {
      const float w = wp[(size_t)kk * 2304];
      a0 += sh[kk] * w;
      a1 += sh[64 + kk] * w;
      a2 += sh[128 + kk] * w;
      a3 += sh[192 + kk] * w;
      a4 += sh[256 + kk] * w;
    }
    float* sp = (float*)(p.ws + OFF_SWPART) + ((size_t)(kc * 4 + L) * 5) * 2304 + n;
    sp[0] = a0; sp[2304] = a1; sp[2 * 2304] = a2; sp[3 * 2304] = a3; sp[4 * 2304] = a4;
  }
}

DI void sincos_d(double a, double& sn, double& cs) {
  const double twopi = 6.283185307179586476925;
  const double n = rint(a / twopi);
  const double x = a - n * twopi;
  const double x2 = x * x;
  double ts = x, tc = 1.0, s = x, c = 1.0;
#pragma unroll 1
  for (int k = 1; k <= 16; ++k) {
    tc = -tc * x2 / (double)((2 * k - 1) * (2 * k));
    ts = -ts * x2 / (double)((2 * k) * (2 * k + 1));
    c += tc;
    s += ts;
  }
  sn = s;
  cs = c;
}

__global__ void __launch_bounds__(512, 2) fwd_megakernel(Params p) {
  cg::grid_group grid = cg::this_grid();
  __shared__ __attribute__((aligned(16))) unsigned char sm[SMEM_TOTAL];
  uint4& xb_words = *(uint4*)(sm + L_XB);
  const int nblk = gridDim.x;
  const int wave_s = __builtin_amdgcn_readfirstlane((int)(threadIdx.x >> 6));
  if (p.ws == nullptr) grid.sync();
  const bool is_t0 = (TIDX == 0);
  if (is_t0) xb_words = make_uint4(0u, 0u, 0u, 0u);
  __syncthreads();
  (void)xcd_barrier_post((unsigned*)(p.ws + OFF_BAR), (volatile LAS unsigned*)&xb_words, is_t0);
#define GRID_SYNC()                                            \
  do {                                                         \
    XcdBarrier xb_;                                            \
    xb_.bar = (unsigned*)(p.ws + opq_o(OFF_BAR));              \
    xb_.x = xb_xcc_id();                                       \
    xb_.st = (volatile LAS unsigned*)&xb_words;                \
    xcd_barrier(xb_, TIDX == 0);                               \
  } while (0)

  {
    const int tid = TIDX;
    constexpr int TOTAL = 4 * N_TPAIR + 4 * 48 + 1;
    for (int item = blockIdx.x; item < TOTAL; item += nblk) {
      __syncthreads();
      if (item < 4 * N_TPAIR) {
        weight_pair_item(p, item / N_TPAIR, item % N_TPAIR, sm, wave_s);
      } else if (item < 4 * N_TPAIR + 192) {
        mod_item(p, (item - 4 * N_TPAIR) / 48, (item - 4 * N_TPAIR) % 48, sm, wave_s);
      } else {
        float2* rc = (float2*)(p.ws + OFF_ROPE);
        for (int idx = tid; idx < 1024; idx += 512) {
          const int pos = idx >> 4, fi = idx & 15;
          const float inv = __builtin_amdgcn_exp2f(-(float)fi * (1.f / 16.f) * 13.287712379549449f);
          const float ang = (float)pos * inv;
          double sn, cs;
          sincos_d((double)ang, sn, cs);
          rc[idx] = make_float2((float)cs, (float)sn);
        }
      }
    }
  }
  GRID_SYNC();
  {
    for (int item = blockIdx.x; item < 4 * N_SWITEM; item += nblk) {
      __syncthreads();
      sw_item(p, item / N_SWITEM, item % N_SWITEM, sm, wave_s);
    }
    const float* mod = (const float*)(p.ws + OFF_MOD);
    ushort_t* xg = (ushort_t*)(p.ws + OFF_XG);
    float* rowss = (float*)(p.ws + OFF_ROWSS);
    const int tidr = TIDX, lane = tidr & 63;
    const int rstride = nblk * 8;
    for (int row0 = blockIdx.x * 8 + (tidr >> 6); row0 < NTOK; row0 += 6 * rstride) {
      float4 v[6][4];
      bool ok[6];
#pragma unroll
      for (int u = 0; u < 6; ++u) {
        const int row = row0 + u * rstride;
        ok[u] = row < NTOK;
        const int rw = ok[u] ? row : row0;
        const float* src = rw < NCTX ? p.x_prompt + (size_t)rw * 1024 : p.x_sample + (size_t)(rw - NCTX) * 1024;
#pragma unroll
        for (int i = 0; i < 4; ++i) v[u][i] = *(const float4*)(src + lane * 4 + 256 * i);
      }
#pragma unroll
      for (int u = 0; u < 6; ++u) {
        const int row = row0 + u * rstride;
        if (!ok[u]) continue;
        const float* scl = mod + (size_t)mod_row(row) * 3072 + 1024;
        float ss = 0.f;
#pragma unroll
        for (int i = 0; i < 4; ++i) {
          const int n = lane * 4 + 256 * i;
          const float4 x4 = v[u][i];
          const float4 sc = *(const float4*)(scl + n);
          const float4 w4 = *(const float4*)(p.norm_w + n);
          ss += (x4.x * x4.x + x4.y * x4.y) + (x4.z * x4.z + x4.w * x4.w);
          uint2 o;
          o.x = pack2(x4.x * (w4.x * (1.f + sc.x)), x4.y * (w4.y * (1.f + sc.y)));
          o.y = pack2(x4.z * (w4.z * (1.f + sc.z)), x4.w * (w4.w * (1.f + sc.w)));
          *(uint2*)(xg + (size_t)row * 1024 + n) = o;
        }
#pragma unroll
        for (int off = 32; off >= 1; off >>= 1) ss += __shfl_xor(ss, off);
        if (lane < 8) rowss[(size_t)row * 8 + lane] = lane == 0 ? ss : 0.f;
      }
    }
  }
  GRID_SYNC();
#pragma unroll 1
  for (int l = 0; l < 4; ++l) {
    phase_inproj(p, l, sm, wave_s);
    GRID_SYNC();
    if (nblk == 256) {
      const int xq = blockIdx.x & 7, rq = blockIdx.x >> 3;
      __syncthreads();
      attn_item(p, l, (rq >> 3) * 64 + ((rq >> 2) & 1) * 32 + 4 * xq + (rq & 3), sm, wave_s);
      __syncthreads();
      if (rq < 16) {
        attn_item(p, l, 256 + (xq + 8 * (rq >> 3)) * 8 + ((rq >> 2) & 1) * 4 + (rq & 3), sm, wave_s);
      } else {
        const int e = rq - 16;
        pool_item(p, l, (2 * (xq + 8 * (e >> 3)) + ((e >> 2) & 1)) * 4 + (e & 3), sm, wave_s);
      }
      __syncthreads();
      {
        const int e = 16 + rq;
        pool_item(p, l, (2 * (xq + 8 * (e >> 3)) + ((e >> 2) & 1)) * 4 + (e & 3), sm, wave_s);
      }
    } else {
      for (int item = blockIdx.x; item < 384 + 384; item += nblk) {
        __syncthreads();
        if (item < 384) attn_item(p, l, item, sm, wave_s);
        else pool_item(p, l, item - 384, sm, wave_s);
      }
    }
    GRID_SYNC();
    phase_outproj(p, l, sm, wave_s);
    GRID_SYNC();
  }
  {
    const float* xws = (const float*)(p.ws + OFF_X);
    const float* rowss = (const float*)(p.ws + OFF_ROWSS);
    const int tidr = TIDX, lane = tidr & 63;
    const int rstride = nblk * 8;
    for (int row0 = blockIdx.x * 8 + (tidr >> 6); row0 < NTOK; row0 += 6 * rstride) {
      float4 v[6][4];
      float rr[6];
#pragma unroll
      for (int u = 0; u < 6; ++u) {
        const int row = (row0 + u * rstride) < NTOK ? (row0 + u * rstride) : row0;
        const float4* rs = (const float4*)(rowss + (size_t)row * 8);
        const float4 s0 = rs[0], s1 = rs[1];
        rr[u] = rsqrtf((((s0.x + s0.y) + (s0.z + s0.w)) + ((s1.x + s1.y) + (s1.z + s1.w))) * (1.f / 1024.f) + EPS);
#pragma unroll
        for (int i = 0; i < 4; ++i) v[u][i] = *(const float4*)(xws + (size_t)row * 1024 + lane * 4 + 256 * i);
      }
#pragma unroll
      for (int u = 0; u < 6; ++u) {
        const int row = row0 + u * rstride;
        if (row >= NTOK) continue;
#pragma unroll
        for (int i = 0; i < 4; ++i) {
          const int n = lane * 4 + 256 * i;
          const float4 w4 = *(const float4*)(p.final_norm + n);
          const float4 x4 = v[u][i];
          *(float4*)(p.out + (size_t)row * 1024 + n) =
              make_float4(x4.x * rr[u] * w4.x, x4.y * rr[u] * w4.y, x4.z * rr[u] * w4.z, x4.w * rr[u] * w4.w);
        }
      }
    }
  }
}

extern "C" void kernel_launch(void* const* d_in, const int* in_sizes, int n_in, void* d_out, int out_size, void* d_ws,
                              size_t ws_size, hipStream_t stream) {
  static int grid_blocks = 0;
  if (!grid_blocks) {
    int dev = 0, cus = 0, per_cu = 0;
    (void)hipGetDevice(&dev);
    (void)hipDeviceGetAttribute(&cus, hipDeviceAttributeMultiprocessorCount, dev);
    (void)hipOccupancyMaxActiveBlocksPerMultiprocessor(&per_cu, fwd_megakernel, 512, 0);
    if (per_cu < 1) fprintf(stderr, "occupancy query reports %d blocks per CU\n", per_cu);
    grid_blocks = cus;
  }
  Params p{};
  p.x_prompt = (const float*)d_in[0];
  p.x_sample = (const float*)d_in[1];
  p.cache_k = (const float*)d_in[2];
  p.cache_v = (const float*)d_in[3];
  p.c = (const float*)d_in[4];
  p.c_ctx = (const float*)d_in[5];
  p.norm_w = (const float*)d_in[6];
  p.w_ada = (const float*)d_in[7];
  p.b_ada = (const float*)d_in[8];
  p.w_in = (const float*)d_in[9];
  p.sink = (const float*)d_in[10];
  p.attn_norm = (const float*)d_in[11];
  p.pool_norm = (const float*)d_in[12];
  p.w_pool = (const float*)d_in[13];
  p.pool_scale = (const float*)d_in[14];
  p.w_out = (const float*)d_in[15];
  p.final_norm = (const float*)d_in[16];
  p.out = (float*)d_out;
  p.ws = (unsigned char*)d_ws;
  (void)hipMemsetAsync((unsigned char*)d_ws + OFF_BAR, 0, XCD_BAR_WORDS * 4, stream);
  void* args[] = {&p};
  hipError_t e = hipLaunchCooperativeKernel((void*)fwd_megakernel, dim3(grid_blocks), dim3(512), args, 0, stream);
  if (e != hipSuccess) fprintf(stderr, "cooperative launch failed: %s (grid %d)\n", hipGetErrorString(e), grid_blocks);
}
```

```cpp
#include <hip/hip_runtime.h>
#include <hip/hip_cooperative_groups.h>
#include <cstdio>
namespace cg = cooperative_groups;

typedef __attribute__((ext_vector_type(8))) short bf16x8;
typedef __attribute__((ext_vector_type(4))) short s16x4;
typedef __attribute__((ext_vector_type(16))) float f32x16;
typedef __attribute__((ext_vector_type(4))) float f32x4;
typedef __bf16 bf2_t __attribute__((ext_vector_type(2)));
typedef float f2_t __attribute__((ext_vector_type(2)));
typedef unsigned short ushort_t;

#define DI __device__ __forceinline__
#define MFMA32(a, b, c) __builtin_amdgcn_mfma_f32_32x32x16_bf16((a), (b), (c), 0, 0, 0)

constexpr int NTOK = 12288, NCTX = 4096, DM = 1024, INW = 2304;
constexpr float EPS = 1e-6f;
constexpr float LOG2E = 1.4426950408889634f;

constexpr size_t OFF_WTIN = 0;
constexpr size_t OFF_WTOUT = OFF_WTIN + 4ull * 2304 * 1024 * 2;
constexpr size_t OFF_WTPOOL = OFF_WTOUT + 4ull * 1024 * 1024 * 2;
constexpr size_t OFF_MODPART = OFF_WTPOOL + 4ull * 4 * 128 * 128 * 2;
constexpr size_t OFF_MOD = OFF_MODPART + 16ull * 4 * 5 * 3072 * 4;
constexpr size_t OFF_SWPART = OFF_MOD + 4ull * 5 * 3072 * 4;
constexpr size_t OFF_SW = OFF_SWPART + 16ull * 4 * 5 * 2304 * 4;
constexpr size_t OFF_ROPE = OFF_SW + 4ull * 5 * 2304 * 4;
constexpr size_t OFF_X = OFF_ROPE + 64 * 16 * 8;
constexpr size_t OFF_XG = OFF_X + 12288ull * 1024 * 4;
constexpr size_t OFF_P = OFF_XG + 12288ull * 1024 * 2;
constexpr size_t OFF_AM = OFF_P + 12288ull * 2304 * 2;
constexpr size_t OFF_ROWSS = OFF_AM + 12288ull * 1024 * 2;
constexpr size_t OFF_SSA = OFF_ROWSS + 12288ull * 16 * 4;
constexpr size_t OFF_SSP = OFF_SSA + 12288ull * 8 * 4;
constexpr size_t OFF_BAR = OFF_SSP + 12288ull * 8 * 4;
constexpr size_t OFF_X1 = OFF_BAR + 16384;

constexpr int SMEM_BYTES = 131072;
constexpr int L_RATIO = SMEM_BYTES;
constexpr int L_RP = L_RATIO + 1024;
constexpr int L_GG = L_RP + 1024;
constexpr int L_SW = L_GG + 2048;
constexpr int L_RR = L_SW + 1024;
constexpr int L_ROPE = L_RR + 1024;
constexpr int L_XB = L_ROPE + 8192;
constexpr int SMEM_TOTAL = L_XB + 16;

struct Params {
  const float *x_prompt, *x_sample, *cache_k, *cache_v, *c, *c_ctx, *norm_w, *w_ada, *b_ada, *w_in, *sink, *attn_norm,
      *pool_norm, *w_pool, *pool_scale, *w_out, *final_norm;
  float* out;
  unsigned char* ws;
};

DI unsigned pack2(float a, float b) {
  f2_t v = {a, b};
  return __builtin_bit_cast(unsigned, __builtin_convertvector(v, bf2_t));
}
DI float bflo(unsigned u) { return __uint_as_float(u << 16); }
DI float bfhi(unsigned u) { return __uint_as_float(u & 0xffff0000u); }
DI float silu_f(float x) { return x * __builtin_amdgcn_rcpf(1.f + __expf(-x)); }
DI int opq(int x) { asm volatile("" : "+v"(x)); return x; }
DI int lane_id_v() {
  int r;
  asm volatile("v_mbcnt_lo_u32_b32 %0, -1, 0\n\tv_mbcnt_hi_u32_b32 %0, -1, %0" : "=v"(r));
  return r;
}
#define TIDX (wave_s * 64 + lane_id_v())
DI size_t opq_o(size_t o) { asm volatile("" : "+s"(o)); return o; }
DI int crow(int i, int h) { return (i & 3) + 8 * (i >> 2) + 4 * h; }


#define XB_TMO      128
#define XB_XCNT(j)  (256  + 64 * (j))
#define XB_XSUB(j)  (1280 + 64 * (j))
#define XB_XGEN(j)  (2304 + 64 * (j))
#define XB_TOP      3328
#define XB_TOPGEN   3392
#define XCD_BAR_WORDS 3456
#define XB_SPIN_CAP (1u << 18)
#define LAS __attribute__((address_space(3)))
DI unsigned xb_ld(unsigned* p) { return __hip_atomic_load(p, __ATOMIC_RELAXED, __HIP_MEMORY_SCOPE_AGENT); }
DI unsigned xb_add(unsigned* p, unsigned v) { return __hip_atomic_fetch_add(p, v, __ATOMIC_RELAXED, __HIP_MEMORY_SCOPE_AGENT); }
DI unsigned xb_xcc_id() { return (unsigned)__builtin_amdgcn_s_getreg((3 << 11) | 20) & 0xFu; }
#define XB_SPIN(cond, bar) do { unsigned _sp = 0; while (cond) { __builtin_amdgcn_s_sleep(1); \
    if ((++_sp & 255u) == 0u) { if (xb_ld(&(bar)[XB_TMO])) break; if (_sp > XB_SPIN_CAP) { atomicAdd(&(bar)[XB_TMO], 1u); break; } } } } while (0)
struct XcdBarrier { unsigned* bar; unsigned x; volatile LAS unsigned* st; };
DI XcdBarrier xcd_barrier_post(unsigned* bar, volatile LAS unsigned* st, bool is_t0) {
  XcdBarrier b; b.bar = bar; b.x = xb_xcc_id(); b.st = st;
  if (is_t0) (void)xb_add(&bar[XB_XCNT(b.x)], 1u);
  return b;
}
DI void xcd_barrier_complete(unsigned* bar, unsigned x, unsigned& nloc, unsigned& nx) {
  const unsigned G = gridDim.x * gridDim.y * gridDim.z;
  unsigned sum, cnt, mine, sp = 0u;
  for (;;) {
    sum = 0u; cnt = 0u; mine = 0u;
#pragma unroll
    for (unsigned j = 0; j < 16; ++j) { const unsigned c = xb_ld(&bar[XB_XCNT(j)]); sum += c; cnt += (c > 0u) ? 1u : 0u; mine = (j == x) ? c : mine; }
    if (sum == G) break;
    __builtin_amdgcn_s_sleep(1);
    if ((++sp & 255u) == 0u) { if (xb_ld(&bar[XB_TMO])) break; if (sp > XB_SPIN_CAP) { atomicAdd(&bar[XB_TMO], 1u); break; } }
  }
  nloc = mine > 0u ? mine : 1u; nx = cnt > 0u ? cnt : 1u;
}
DI void xcd_barrier(const XcdBarrier& b, bool is_t0) {
  asm volatile("s_waitcnt vmcnt(0)" ::: "memory");
  __syncthreads();
  if (is_t0) {
    unsigned* bar = b.bar;
    __builtin_amdgcn_s_waitcnt(0);
    unsigned nloc = b.st[0], nx = b.st[1];
    if (nloc == 0u) { xcd_barrier_complete(bar, b.x, nloc, nx); b.st[0] = nloc; b.st[1] = nx; }
    const unsigned old = xb_add(&bar[XB_XSUB(b.x)], 1u);
    const unsigned gen = old / nloc;
    if (old + 1u == (gen + 1u) * nloc) {
      __builtin_amdgcn_fence(__ATOMIC_RELEASE, "agent");
      asm volatile("s_waitcnt vmcnt(0)" ::: "memory");
      const unsigned og = xb_add(&bar[XB_TOP], 1u);
      const unsigned tg = og / nx;
      if (og + 1u == (tg + 1u) * nx) xb_add(&bar[XB_TOPGEN], 1u);
      else XB_SPIN(xb_ld(&bar[XB_TOPGEN]) == tg, bar);
      __builtin_amdgcn_fence(__ATOMIC_ACQUIRE, "agent");
      xb_add(&bar[XB_XGEN(b.x)], 1u);
      asm volatile("s_waitcnt vmcnt(0)" ::: "memory");
    } else {
      XB_SPIN(xb_ld(&bar[XB_XGEN(b.x)]) == gen, bar);
      __builtin_amdgcn_fence(__ATOMIC_ACQUIRE, "agent");
      asm volatile("s_waitcnt vmcnt(0)" ::: "memory");
    }
  }
  __syncthreads();
}


constexpr int G_HT = 128 * 64;
DI int lds_byte(int r, int c) {
  int st = (r >> 4) * 2 + (c >> 5), rr = r & 15, cc = c & 31, ob = rr * 64 + cc * 2;
  return st * 1024 + (ob ^ (((ob >> 9) & 1) << 5));
}
DI void stage_rc(int b, int& R, int& C) {
  int st = b / 1024, sb = b % 1024, swz = sb ^ (((sb >> 9) & 1) << 5);
  R = (st >> 1) * 16 + swz / 64;
  C = (st & 1) * 32 + (swz % 64) / 2;
}

template <class Mid>
DI void gemm256(const ushort_t* __restrict__ A, const ushort_t* __restrict__ Bt, f32x4 (&acc)[2][2][4][2],
                unsigned char* shm_, Mid mid, const int wave_s) {
  constexpr int K = 1024, BK = 64, HALF = 128, nt = K / BK;
  ushort_t* shm = (ushort_t*)shm_;
  const int tid = TIDX;
  const int wid = tid >> 6, lane = tid & 63, wr = wid >> 2, wc = wid & 3, fr = lane & 15, fq = lane >> 4;
  unsigned go0, go1;
  {
    int r_, c_;
    stage_rc(tid * 16, r_, c_);
    go0 = (unsigned)(r_ * K + c_) * 2u;
    stage_rc(tid * 16 + 8192, r_, c_);
    go1 = (unsigned)(r_ * K + c_) * 2u;
  }
#define SA(b, h) (shm + ((b) * 2 + (h)) * G_HT)
#define SB(b, h) (shm + (4 + (b) * 2 + (h)) * G_HT)
#define STAGE(P, BASE, br, kt)                                                                                      \
  do {                                                                                                              \
    const char* _g = (const char*)((BASE) + (size_t)(br) * K + (kt) * BK);                                          \
    __builtin_amdgcn_global_load_lds((const unsigned*)(_g + go0), (LAS unsigned*)((char*)(P) + wave_s * 1024), 16, 0, 0); \
    __builtin_amdgcn_global_load_lds((const unsigned*)(_g + go1), (LAS unsigned*)((char*)(P) + wave_s * 1024 + 8192), 16, 0, 0); \
  } while (0)
#define LDA(dst, b, h)                                                                                              \
  _Pragma("unroll") for (int m = 0; m < 4; ++m) _Pragma("unroll") for (int k = 0; k < 2; ++k)                       \
      dst[m][k] = *reinterpret_cast<const bf16x8*>((char*)SA(b, h) + lds_byte(wr * 64 + m * 16 + fr, k * 32 + fq * 8))
#define LDB(dst, b, h)                                                                                              \
  _Pragma("unroll") for (int n = 0; n < 2; ++n) _Pragma("unroll") for (int k = 0; k < 2; ++k)                       \
      dst[n][k] = *reinterpret_cast<const bf16x8*>((char*)SB(b, h) + lds_byte(wc * 32 + n * 16 + fr, k * 32 + fq * 8))
#define MMA(ai, bj, At_, Bt_)                                                                                       \
  do {                                                                                                              \
    __builtin_amdgcn_s_setprio(1);                                                                                  \
    _Pragma("unroll") for (int m = 0; m < 4; ++m) _Pragma("unroll") for (int n = 0; n < 2; ++n)                     \
        _Pragma("unroll") for (int k = 0; k < 2; ++k) acc[ai][bj][m][n] =                                           \
            __builtin_amdgcn_mfma_f32_16x16x32_bf16(At_[m][k], Bt_[n][k], acc[ai][bj][m][n], 0, 0, 0);              \
    __builtin_amdgcn_s_setprio(0);                                                                                  \
  } while (0)
#define WAIT_V(n) asm volatile("s_waitcnt vmcnt(" #n ")" ::: "memory")
#define WAIT_L(n) asm volatile("s_waitcnt lgkmcnt(" #n ")" ::: "memory")
#define BAR __builtin_amdgcn_s_barrier()
#define SCHED __builtin_amdgcn_sched_barrier(0)
  bf16x8 At[4][2], B0[2][2], B1[2][2];
  STAGE(SB(0, 0), Bt, 0, 0); STAGE(SA(0, 0), A, 0, 0);
  STAGE(SB(0, 1), Bt, HALF, 0); STAGE(SA(0, 1), A, HALF, 0);
  if (wr == 1) BAR;
  WAIT_V(4); BAR;
  STAGE(SB(1, 0), Bt, 0, 1); STAGE(SA(1, 0), A, 0, 1); STAGE(SB(1, 1), Bt, HALF, 1);
  WAIT_V(6); BAR;
#pragma unroll 1
  for (int t = 0; t < nt - 2; t += 2) {
    if (t == nt / 2) mid(acc);
    LDB(B0, 0, 0); SCHED; LDA(At, 0, 0); STAGE(SA(1, 1), A, HALF, t + 1);
    WAIT_L(8); BAR; WAIT_L(0); MMA(0, 0, At, B0); BAR; SCHED;
    LDB(B1, 0, 1); STAGE(SB(0, 0), Bt, 0, t + 2);
    BAR; WAIT_L(0); MMA(0, 1, At, B1); BAR;
    LDA(At, 0, 1); STAGE(SA(0, 0), A, 0, t + 2);
    BAR; WAIT_L(0); MMA(1, 0, At, B0); BAR; SCHED;
    STAGE(SB(0, 1), Bt, HALF, t + 2);
    WAIT_V(6); BAR; MMA(1, 1, At, B1); BAR;
    LDB(B0, 1, 0); SCHED; LDA(At, 1, 0); STAGE(SA(0, 1), A, HALF, t + 2);
    WAIT_L(8); BAR; WAIT_L(0); MMA(0, 0, At, B0); BAR; SCHED;
    LDB(B1, 1, 1); STAGE(SB(1, 0), Bt, 0, t + 3);
    BAR; WAIT_L(0); MMA(0, 1, At, B1); BAR;
    LDA(At, 1, 1); STAGE(SA(1, 0), A, 0, t + 3);
    BAR; WAIT_L(0); MMA(1, 0, At, B0); BAR; SCHED;
    STAGE(SB(1, 1), Bt, HALF, t + 3);
    WAIT_V(6); BAR; MMA(1, 1, At, B1); BAR;
  }
  {
    LDB(B0, 0, 0); LDA(At, 0, 0); STAGE(SA(1, 1), A, HALF, nt - 1);
    BAR; WAIT_L(0); MMA(0, 0, At, B0); BAR;
    LDB(B1, 0, 1); BAR; WAIT_L(0); MMA(0, 1, At, B1); BAR;
    LDA(At, 0, 1); WAIT_V(4); BAR; WAIT_L(0); MMA(1, 0, At, B0); MMA(1, 1, At, B1); BAR;
  }
  {
    LDB(B0, 1, 0); LDA(At, 1, 0); WAIT_V(2); BAR; WAIT_L(0); MMA(0, 0, At, B0); BAR;
    LDB(B1, 1, 1); WAIT_V(0); BAR; WAIT_L(0); MMA(0, 1, At, B1); BAR;
    LDA(At, 1, 1); BAR; WAIT_L(0); MMA(1, 0, At, B0); MMA(1, 1, At, B1); BAR;
  }
  if (wr == 0) BAR;
#undef SA
#undef SB
#undef STAGE
#undef LDA
#undef LDB
#undef MMA
}

constexpr int N_TPAIR = 72 + 32 + 8;
DI void weight_pair_item(const Params& p, int L, int it, unsigned char* sm, const int wave_s);
DI void sw_item(const Params& p, int L, int it, unsigned char* sm, const int wave_s);
constexpr int N_SWITEM = 16 * 5;
DI int mod_row(int m0) { return m0 < NCTX ? 0 : 1 + ((m0 - NCTX) >> 11); }


DI void phase_inproj(const Params& p, int l, unsigned char* sm, const int wave_s) {
  const ushort_t* WtIn = (const ushort_t*)(p.ws + opq_o(OFF_WTIN)) + (size_t)l * 2304 * 1024;
  const ushort_t* xg = (const ushort_t*)(p.ws + opq_o(OFF_XG));
  ushort_t* P = (ushort_t*)(p.ws + opq_o(OFF_P));
  const float* rowss = (const float*)(p.ws + opq_o(OFF_ROWSS));
  const float* swpart = (const float*)(p.ws + opq_o(OFF_SWPART));
  const float2* ropecs = (const float2*)(p.ws + opq_o(OFF_ROPE));
  {
    const int tid0 = TIDX;
    ((uint4*)(sm + L_ROPE))[tid0] = ((const uint4*)ropecs)[tid0];
  }
  for (int t = blockIdx.x; t < 9 * 48; t += gridDim.x) {
    const int pn = (t & 7) + 8 * ((t >> 3) / 9), pm = (t >> 3) % 9;
    const int brow = pm * 256, bcol = pn * 256;
    const bool lat = bcol >= NCTX;
    const int bidx = mod_row(bcol);
    f32x4 acc[2][2][4][2];
#pragma unroll
    for (int a = 0; a < 2; ++a)
#pragma unroll
      for (int b = 0; b < 2; ++b)
#pragma unroll
        for (int m = 0; m < 4; ++m)
#pragma unroll
          for (int n = 0; n < 2; ++n) acc[a][b][m][n] = (f32x4){0.f, 0.f, 0.f, 0.f};
    __syncthreads();
    {
      const int tid1 = TIDX;
      if (tid1 < 256) {
        const float* sp_ = swpart + (size_t)(l * 5 + bidx) * 2304 + brow + tid1;
        float s = 0.f;
#pragma unroll
        for (int kc = 0; kc < 16; ++kc) s += sp_[(size_t)kc * 46080];
        ((float*)(sm + L_SW))[tid1] = s;
      } else {
        const int tl = tid1 - 256;
        const float4* rs = (const float4*)(rowss + (size_t)(bcol + tl) * 8);
        const float4 s0 = rs[0], s1 = rs[1];
        const float ss = ((s0.x + s0.y) + (s0.z + s0.w)) + ((s1.x + s1.y) + (s1.z + s1.w));
        ((float*)(sm + L_RR))[tl] = rsqrtf(ss * (1.f / 1024.f) + EPS);
      }
    }
    gemm256(WtIn + (size_t)brow * 1024, xg + (size_t)bcol * 1024, acc, sm, [](f32x4(&)[2][2][4][2]) {}, wave_s);
    const int tid2 = TIDX, wid2 = tid2 >> 6, lane2 = tid2 & 63;
    const int wr = wid2 >> 2, wc = wid2 & 3, fr = lane2 & 15, fq = lane2 >> 4;
    const float* swt = (const float*)(sm + L_SW);
    const float* rrt = (const float*)(sm + L_RR);
    const float2* ropeL = (const float2*)(sm + L_ROPE);
#pragma unroll
    for (int bj = 0; bj < 2; ++bj)
#pragma unroll
      for (int n = 0; n < 2; ++n) {
        const int tloc = bj * 128 + wc * 32 + n * 16 + fr;
        const int tk = bcol + tloc;
        const float rr = rrt[tloc];
        const int tpos = (tk - NCTX) & 2047;
#pragma unroll
        for (int ai = 0; ai < 2; ++ai) {
          const int floc = ai * 128 + wr * 64;
          const int f0 = brow + floc;
          float v[4][4];
#pragma unroll
          for (int m = 0; m < 4; ++m) {
            const float4 sv = *(const float4*)(swt + floc + m * 16 + fq * 4);
            v[m][0] = acc[ai][bj][m][n][0] * rr + sv.x;
            v[m][1] = acc[ai][bj][m][n][1] * rr + sv.y;
            v[m][2] = acc[ai][bj][m][n][2] * rr + sv.z;
            v[m][3] = acc[ai][bj][m][n][3] * rr + sv.w;
          }
          if (lat && f0 < 640) {
#pragma unroll
            for (int hlf = 0; hlf < 2; ++hlf) {
              const int pos = hlf == 0 ? (tpos >> 6) : (tpos & 63);
              const float4* cp = (const float4*)(ropeL + pos * 16 + fq * 4);
              const float4 c01 = cp[0], c23 = cp[1];
              const float cs_[4] = {c01.x, c01.z, c23.x, c23.z};
              const float sn_[4] = {c01.y, c01.w, c23.y, c23.w};
#pragma unroll
              for (int e = 0; e < 4; ++e) {
                const float x1 = v[2 * hlf][e], x2 = v[2 * hlf + 1][e];
                v[2 * hlf][e] = x1 * cs_[e] - x2 * sn_[e];
                v[2 * hlf + 1][e] = x2 * cs_[e] + x1 * sn_[e];
              }
            }
          }
          const float qs = f0 < 512 ? 0.125f * LOG2E : 1.f;
#pragma unroll
          for (int m = 0; m < 4; ++m) {
            uint2 o;
            o.x = pack2(v[m][0] * qs, v[m][1] * qs);
            o.y = pack2(v[m][2] * qs, v[m][3] * qs);
            *(uint2*)(P + (size_t)tk * INW + f0 + m * 16 + fq * 4) = o;
          }
          const int f128 = f0 >> 7;
          if (!lat && (f128 == 4 || f128 == 5)) {
            const int b = tk >> 8, s = tk & 255;
            float* dst = p.out + (size_t)12582912 + (f128 == 5 ? (size_t)2097152 : 0) +
                         ((size_t)((b * 4 + l) * 256 + s)) * 128 + (f0 & 127);
#pragma unroll
            for (int m = 0; m < 4; ++m)
              *(float4*)(dst + m * 16 + fq * 4) = make_float4(v[m][0], v[m][1], v[m][2], v[m][3]);
          }
        }
      }
  }
}

DI void phase_outproj(const Params& p, int l, unsigned char* sm, const int wave_s) {
  const ushort_t* WtOut = (const ushort_t*)(p.ws + opq_o(OFF_WTOUT)) + (size_t)l * 1024 * 1024;
  const ushort_t* am = (const ushort_t*)(p.ws + opq_o(OFF_AM));
  ushort_t* xg = (ushort_t*)(p.ws + opq_o(OFF_XG));
  float* xws = (float*)(p.ws + opq_o(OFF_X));
  const float* xprev = xws;
  float* rowss = (float*)(p.ws + opq_o(OFF_ROWSS));
  const float* ssa = (const float*)(p.ws + opq_o(OFF_SSA));
  const float* ssp = (const float*)(p.ws + opq_o(OFF_SSP));
  const float* mod = (const float*)(p.ws + opq_o(OFF_MOD));
  for (int t = blockIdx.x; t < 4 * 48; t += gridDim.x) {
    const int pn = (t & 7) + 8 * ((t >> 3) >> 2), pm = (t >> 3) & 3;
    const int brow = pm * 256, bcol = pn * 256;
    const int bidx = mod_row(bcol);
    f32x4 acc[2][2][4][2];
#pragma unroll
    for (int a = 0; a < 2; ++a)
#pragma unroll
      for (int b = 0; b < 2; ++b)
#pragma unroll
        for (int m = 0; m < 4; ++m)
#pragma unroll
          for (int n = 0; n < 2; ++n) acc[a][b][m][n] = (f32x4){0.f, 0.f, 0.f, 0.f};
    __syncthreads();
    {
      const int tid1 = TIDX;
      if (tid1 < 256) {
        const int tk = bcol + tid1;
        const float4* pa = (const float4*)(ssa + (size_t)tk * 8);
        const float4* pp = (const float4*)(ssp + (size_t)tk * 8);
        const float4 a0 = pa[0], a1 = pa[1], b0 = pp[0], b1 = pp[1];
        const float sa_ = ((a0.x + a0.y) + (a0.z + a0.w)) + ((a1.x + a1.y) + (a1.z + a1.w));
        const float sp_ = ((b0.x + b0.y) + (b0.z + b0.w)) + ((b1.x + b1.y) + (b1.z + b1.w));
        const float ra = rsqrtf(sa_ * (1.f / 512.f) + EPS), rpv = rsqrtf(sp_ * (1.f / 512.f) + EPS);
        ((float*)(sm + L_RATIO))[tid1] = ra / rpv;
        ((float*)(sm + L_RP))[tid1] = rpv;
      } else {
        const int f = brow + tid1 - 256;
        const float gt = mod[(size_t)(l * 5 + bidx) * 3072 + 2048 + f];
        float gn = 0.f;
        if (l < 3) gn = p.norm_w[(size_t)(l + 1) * 1024 + f] * (1.f + mod[(size_t)((l + 1) * 5 + bidx) * 3072 + 1024 + f]);
        ((float2*)(sm + L_GG))[tid1 - 256] = make_float2(gt, gn);
      }
    }
    gemm256(WtOut + (size_t)brow * 1024, am + (size_t)bcol * 1024, acc, sm, [&](f32x4(&ac)[2][2][4][2]) {
      const int tidm = TIDX;
      const float* rt = (const float*)(sm + L_RATIO) + ((tidm >> 6) & 3) * 32 + (tidm & 15);
#pragma unroll
      for (int b = 0; b < 2; ++b)
#pragma unroll
        for (int n = 0; n < 2; ++n) {
          const float rv = rt[b * 128 + n * 16];
#pragma unroll
          for (int a = 0; a < 2; ++a)
#pragma unroll
            for (int m = 0; m < 4; ++m) ac[a][b][m][n] *= rv;
          __builtin_amdgcn_sched_barrier(0);
        }
    }, wave_s);
    const int tid2 = TIDX, wid2 = tid2 >> 6, lane2 = tid2 & 63;
    const int wr = wid2 >> 2, wc = wid2 & 3, fr = lane2 & 15, fq = lane2 >> 4;
    const int tk0 = bcol + wc * 32 + fr;
    const float* xsrc0 = (l == 0) ? (tk0 < NCTX ? p.x_prompt + (size_t)tk0 * 1024 : p.x_sample + (size_t)(tk0 - NCTX) * 1024)
                                  : xprev + (size_t)tk0 * 1024;
    const float* rpt = (const float*)(sm + L_RP) + wc * 32 + fr;
    const float rp[2][2] = {{rpt[0], rpt[16]}, {rpt[128], rpt[144]}};
    const float4* ggt = (const float4*)(sm + L_GG);
    float ssq[2][2] = {{0.f, 0.f}, {0.f, 0.f}};
#pragma unroll
    for (int ai = 0; ai < 2; ++ai) {
      float4 xv[4][2][2];
#pragma unroll
      for (int m = 0; m < 4; ++m)
#pragma unroll
        for (int bj = 0; bj < 2; ++bj)
#pragma unroll
          for (int n = 0; n < 2; ++n)
            xv[m][bj][n] = *(const float4*)(xsrc0 + (size_t)(bj * 128 + n * 16) * 1024 + brow + ai * 128 + wr * 64 + m * 16 + fq * 4);
#pragma unroll
      for (int m = 0; m < 4; ++m) {
        const int floc = ai * 128 + wr * 64 + m * 16 + fq * 4;
        const int f = brow + floc;
        const float4 g01 = ggt[(floc >> 1)], g23 = ggt[(floc >> 1) + 1];
#pragma unroll
        for (int bj = 0; bj < 2; ++bj)
#pragma unroll
          for (int n = 0; n < 2; ++n) {
            const int toff = bj * 128 + n * 16;
            const float rpv = rp[bj][n];
            const float4 x4 = xv[m][bj][n];
            float4 xn;
            xn.x = x4.x + g01.x * (acc[ai][bj][m][n][0] * rpv);
            xn.y = x4.y + g01.z * (acc[ai][bj][m][n][1] * rpv);
            xn.z = x4.z + g23.x * (acc[ai][bj][m][n][2] * rpv);
            xn.w = x4.w + g23.z * (acc[ai][bj][m][n][3] * rpv);
            ssq[bj][n] += (xn.x * xn.x + xn.y * xn.y) + (xn.z * xn.z + xn.w * xn.w);
            *(float4*)(xws + (size_t)(tk0 + toff) * 1024 + f) = xn;
            if (l < 3) {
              uint2 o;
              o.x = pack2(xn.x * g01.y, xn.y * g01.w);
              o.y = pack2(xn.z * g23.y, xn.w * g23.w);
              *(uint2*)(xg + (size_t)(tk0 + toff) * 1024 + f) = o;
            }
          }
      }
      __builtin_amdgcn_sched_barrier(0);
    }
#pragma unroll
    for (int bj = 0; bj < 2; ++bj)
#pragma unroll
      for (int n = 0; n < 2; ++n) {
        float s = ssq[bj][n];
        s += __shfl_xor(s, 16);
        s += __shfl_xor(s, 32);
        if (fq == 0) rowss[(size_t)(tk0 + bj * 128 + n * 16) * 8 + pm * 2 + wr] = s;
      }
  }
}

constexpr int AT_KS_BYTES = 320 * 144;
constexpr int AT_VT_STRIDE = 648;
DI void attn_tiles(const unsigned char* Ks, const unsigned char* Vt, int ntile, bool masked, int kbase, int qpos,
                   const bf16x8 (&qf)[4], float& m_run, float& l_run, f32x16 (&o)[2], int r, int h) {
  const int qa = qpos - r;
#pragma unroll 1
  for (int t = 0; t < ntile; ++t) {
    f32x16 s[2];
#pragma unroll
    for (int kt = 0; kt < 2; ++kt) {
#pragma unroll
      for (int i = 0; i < 16; ++i) s[kt][i] = 0.f;
      const unsigned char* kb = Ks + (t * 64 + kt * 32 + r) * 144 + h * 16;
#pragma unroll
      for (int ks = 0; ks < 4; ++ks) {
        const bf16x8 a = *(const bf16x8*)(kb + ks * 32);
        s[kt] = MFMA32(a, qf[ks], s[kt]);
      }
    }
    float mx = -3.0e38f;
    const int kb = kbase + t * 64;
    if (masked && (kb < qa - 97 || kb > qa + 65)) {
#pragma unroll
      for (int kt = 0; kt < 2; ++kt)
#pragma unroll
        for (int i = 0; i < 16; ++i) {
          const int d = qpos - (kb + kt * 32 + crow(i, h));
          float tv = s[kt][i];
          tv = (d > 128 || d < -128) ? -1.0e30f : tv;
          s[kt][i] = tv;
          mx = fmaxf(mx, tv);
        }
    } else {
#pragma unroll
      for (int kt = 0; kt < 2; ++kt)
#pragma unroll
        for (int i = 0; i < 16; ++i) mx = fmaxf(mx, s[kt][i]);
    }
    mx = fmaxf(mx, __shfl_xor(mx, 32));
    const float m_new = fmaxf(m_run, mx);
    const float alpha = __builtin_amdgcn_exp2f(m_run - m_new);
    m_run = m_new;
    f2_t ps2 = {0.f, 0.f};
    const f2_t mm2 = {m_new, m_new};
#pragma unroll
    for (int kt = 0; kt < 2; ++kt)
#pragma unroll
      for (int i = 0; i < 16; i += 2) {
        f2_t v2 = {s[kt][i], s[kt][i + 1]};
        v2 = v2 - mm2;
        f2_t e2 = {__builtin_amdgcn_exp2f(v2.x), __builtin_amdgcn_exp2f(v2.y)};
        s[kt][i] = e2.x;
        s[kt][i + 1] = e2.y;
        ps2 = ps2 + e2;
      }
    const float psum = ps2.x + ps2.y;
    l_run = l_run * alpha + psum;
#pragma unroll
    for (int i = 0; i < 16; ++i) { o[0][i] *= alpha; o[1][i] *= alpha; }
    bf16x8 pf[4];
#pragma unroll
    for (int st = 0; st < 4; ++st) {
      const int kt = st >> 1, s8 = (st & 1) * 8;
      uint4 u;
      u.x = pack2(s[kt][s8 + 0], s[kt][s8 + 1]);
      u.y = pack2(s[kt][s8 + 2], s[kt][s8 + 3]);
      u.z = pack2(s[kt][s8 + 4], s[kt][s8 + 5]);
      u.w = pack2(s[kt][s8 + 6], s[kt][s8 + 7]);
      pf[st] = __builtin_bit_cast(bf16x8, u);
    }
    const unsigned char* vb = Vt + r * AT_VT_STRIDE + (t * 64) * 2 + h * 8;
#pragma unroll
    for (int dt = 0; dt < 2; ++dt)
#pragma unroll
      for (int st = 0; st < 4; ++st) {
        const s16x4 lo = *(const s16x4*)(vb + dt * 32 * AT_VT_STRIDE + st * 32);
        const s16x4 hi = *(const s16x4*)(vb + dt * 32 * AT_VT_STRIDE + st * 32 + 16);
        const bf16x8 a = __builtin_shufflevector(lo, hi, 0, 1, 2, 3, 4, 5, 6, 7);
        o[dt] = MFMA32(a, pf[st], o[dt]);
      }
  }
}

DI void vt_store(unsigned char* Vt, int key, int ch, const uint4& vr) {
  ushort_t* vt = (ushort_t*)(Vt + (ch * 8) * AT_VT_STRIDE) + key;
  constexpr int S = AT_VT_STRIDE / 2;
  vt[0 * S] = (ushort_t)(vr.x & 0xffff);
  vt[1 * S] = (ushort_t)(vr.x >> 16);
  vt[2 * S] = (ushort_t)(vr.y & 0xffff);
  vt[3 * S] = (ushort_t)(vr.y >> 16);
  vt[4 * S] = (ushort_t)(vr.z & 0xffff);
  vt[5 * S] = (ushort_t)(vr.z >> 16);
  vt[6 * S] = (ushort_t)(vr.w & 0xffff);
  vt[7 * S] = (ushort_t)(vr.w >> 16);
}

DI void attn_item(const Params& p, int l, int item, unsigned char* sm, const int wave_s) {
  const ushort_t* P = (const ushort_t*)(p.ws + opq_o(OFF_P));
  ushort_t* am = (ushort_t*)(p.ws + opq_o(OFF_AM));
  float* ssa = (float*)(p.ws + opq_o(OFF_SSA));
  const int tid = TIDX, wave = tid >> 6, lane = tid & 63, r = lane & 31, h = lane >> 5;
  int b, kvh, q0, tokbase, klo, nkb;
  bool lat;
  if (item < 256) {
    lat = true;
    b = item >> 6;
    kvh = (item >> 5) & 1;
    q0 = (item & 31) * 64;
    tokbase = NCTX + b * 2048;
    klo = q0 - 128 < 0 ? 0 : q0 - 128;
    const int khi = q0 + 192 > 2048 ? 2048 : q0 + 192;
    nkb = khi - klo;
  } else {
    const int it = item - 256;
    lat = false;
    b = it >> 3;
    kvh = (it >> 2) & 1;
    q0 = (it & 3) * 64;
    tokbase = b * 256;
    klo = 0;
    nkb = 256;
  }
  const int hq = kvh * 4 + (wave & 3);
  const int qloc = q0 + (wave >> 2) * 32 + r;
  unsigned char* Ks = sm;
  unsigned char* Vt = sm + AT_KS_BYTES;
  {
    const int nch = nkb * 8;
    uint4 kr[5], vr[5];
#pragma unroll
    for (int i = 0; i < 5; ++i) {
      const int c = tid + i * 512;
      const int cc = c < nch ? c : nch - 1;
      const size_t tok = (size_t)(tokbase + klo + (cc >> 3));
      kr[i] = *(const uint4*)(P + tok * INW + 512 + kvh * 64 + (cc & 7) * 8);
      vr[i] = *(const uint4*)(P + tok * INW + 640 + kvh * 64 + (cc & 7) * 8);
    }
#pragma unroll
    for (int i = 0; i < 5; ++i) {
      const int c = tid + i * 512;
      if (c < nch) {
        *(uint4*)(Ks + (c >> 3) * 144 + (c & 7) * 16) = kr[i];
        vt_store(Vt, c >> 3, c & 7, vr[i]);
      }
    }
  }
  bf16x8 qf[4];
  {
    const ushort_t* qp = P + (size_t)(tokbase + qloc) * INW + hq * 64 + h * 8;
#pragma unroll
    for (int ks = 0; ks < 4; ++ks) qf[ks] = *(const bf16x8*)(qp + ks * 16);
  }
  uint2 gav[2][4];
  float4 anw[2][4];
  {
    const ushort_t* gp_ = P + (size_t)(tokbase + qloc) * INW + 768 + hq * 64 + 4 * h;
#pragma unroll
    for (int dt = 0; dt < 2; ++dt)
#pragma unroll
      for (int g = 0; g < 4; ++g) {
        gav[dt][g] = *(const uint2*)(gp_ + dt * 32 + 8 * g);
        anw[dt][g] = *(const float4*)(p.attn_norm + l * 512 + hq * 64 + dt * 32 + 8 * g + 4 * h);
      }
  }
  float m_run = p.sink[l * 8 + hq] * LOG2E;
  float l_run = (h == 0) ? 1.f : 0.f;
  f32x16 o[2];
#pragma unroll
  for (int i = 0; i < 16; ++i) { o[0][i] = 0.f; o[1][i] = 0.f; }
  uint4 ck[4], cv[4];
#pragma unroll
  for (int i = 0; i < 4; ++i) { ck[i] = make_uint4(0, 0, 0, 0); cv[i] = make_uint4(0, 0, 0, 0); }
  if (lat) {
    const size_t base = (size_t)((b * 4 + l) * 256);
#pragma unroll
    for (int i = 0; i < 4; ++i) {
      const int c = tid + i * 512;
      const int key = c >> 3, ch = c & 7;
      const float4* kp = (const float4*)(p.cache_k + (base + key) * 128 + kvh * 64 + ch * 8);
      const float4* vp = (const float4*)(p.cache_v + (base + key) * 128 + kvh * 64 + ch * 8);
      const float4 k0 = kp[0], k1 = kp[1], v0 = vp[0], v1 = vp[1];
      ck[i] = make_uint4(pack2(k0.x, k0.y), pack2(k0.z, k0.w), pack2(k1.x, k1.y), pack2(k1.z, k1.w));
      cv[i] = make_uint4(pack2(v0.x, v0.y), pack2(v0.z, v0.w), pack2(v1.x, v1.y), pack2(v1.z, v1.w));
    }
  }
  __syncthreads();
  attn_tiles(Ks, Vt, nkb >> 6, lat, klo, qloc, qf, m_run, l_run, o, r, h);
  if (lat) {
    __syncthreads();
#pragma unroll
    for (int i = 0; i < 4; ++i) {
      const int c = tid + i * 512;
      const int key = c >> 3, ch = c & 7;
      *(uint4*)(Ks + key * 144 + ch * 16) = ck[i];
      vt_store(Vt, key, ch, cv[i]);
    }
    __syncthreads();
    attn_tiles(Ks, Vt, 4, false, 0, qloc, qf, m_run, l_run, o, r, h);
  }
  const float l_tot = l_run + __shfl_xor(l_run, 32);
  const float inv = __builtin_amdgcn_rcpf(l_tot);
  const size_t m = (size_t)(tokbase + qloc);
  const float* an = p.attn_norm + l * 512 + hq * 64;
  float ssq = 0.f;
#pragma unroll
  for (int dt = 0; dt < 2; ++dt)
#pragma unroll
    for (int g = 0; g < 4; ++g) {
      const int d = dt * 32 + 8 * g + 4 * h;
      const uint2 gavv = gav[dt][g];
      const float4 w4 = anw[dt][g];
      const float o0 = o[dt][4 * g + 0] * inv, o1 = o[dt][4 * g + 1] * inv, o2 = o[dt][4 * g + 2] * inv,
                  o3 = o[dt][4 * g + 3] * inv;
      ssq += (o0 * o0 + o1 * o1) + (o2 * o2 + o3 * o3);
      uint2 ov;
      ov.x = pack2(o0 * w4.x * silu_f(bflo(gavv.x)), o1 * w4.y * silu_f(bfhi(gavv.x)));
      ov.y = pack2(o2 * w4.z * silu_f(bflo(gavv.y)), o3 * w4.w * silu_f(bfhi(gavv.y)));
      *(uint2*)(am + m * 1024 + hq * 64 + d) = ov;
    }
  ssq += __shfl_xor(ssq, 32);
  if (h == 0) ssa[m * 8 + hq] = ssq;
}

template <int HALF>
DI void pool_window(const unsigned char* U, unsigned char* Pm, int t0, int L, int tid) {
  const int cp = tid & 63, seg = tid >> 6;
  const int tl0 = seg * 16;
  const unsigned char* up = U + (tl0 + 8 - HALF) * 272 + cp * 4;
  float s0 = 0.f, s1 = 0.f;
#pragma unroll
  for (int j = 0; j < 2 * HALF; ++j) {
    const unsigned u = *(const unsigned*)(up + j * 272);
    s0 += bflo(u);
    s1 += bfhi(u);
  }
#pragma unroll
  for (int i = 0; i < 16; ++i) {
    const int tl = tl0 + i;
    const int t = t0 + tl;
    const int lo = t - HALF < 0 ? 0 : t - HALF;
    const int hi = t + HALF > L ? L : t + HALF;
    const unsigned xc = *(const unsigned*)(U + (tl + 8) * 272 + cp * 4);
    const float invc = __builtin_amdgcn_rcpf((float)(hi - lo));
    *(unsigned*)(Pm + tl * 272 + cp * 4) = pack2(s0 * invc - bflo(xc), s1 * invc - bfhi(xc));
    if (i < 15) {
      const unsigned ua = *(const unsigned*)(up + (i + 2 * HALF) * 272);
      const unsigned ub = *(const unsigned*)(up + i * 272);
      s0 += bflo(ua) - bflo(ub);
      s1 += bfhi(ua) - bfhi(ub);
    }
  }
}

DI void pool_item(const Params& p, int l, int item, unsigned char* sm, const int wave_s) {
  const ushort_t* P = (const ushort_t*)(p.ws + opq_o(OFF_P));
  ushort_t* am = (ushort_t*)(p.ws + opq_o(OFF_AM));
  float* ssp = (float*)(p.ws + opq_o(OFF_SSP));
  const ushort_t* Wp = (const ushort_t*)(p.ws + opq_o(OFF_WTPOOL));
  const int tid = TIDX, wave = tid >> 6, lane = tid & 63, r = lane & 31, h = lane >> 5;
  const int tt = item >> 2, g = item & 3;
  const int m0 = tt * 128;
  int L, sbase;
  if (m0 < NCTX) { L = 256; sbase = m0 & ~255; } else { L = 2048; sbase = NCTX + ((m0 - NCTX) & ~2047); }
  const int t0 = m0 - sbase;
  unsigned char* U = sm;
  unsigned char* W = sm + 39168;
  unsigned char* Pm = sm + 39168 + 34816;
  const ushort_t* wsrc = Wp + (size_t)(l * 4 + g) * 128 * 128;
  {
    uint4 uu[5], ww[4];
#pragma unroll
    for (int i = 0; i < 5; ++i) {
      const int c = tid + i * 512;
      const int row = c >> 4, ch = c & 15;
      const int pos = t0 - 8 + row;
      uu[i] = make_uint4(0, 0, 0, 0);
      if (c < 144 * 16 && pos >= 0 && pos < L) uu[i] = *(const uint4*)(P + (size_t)(sbase + pos) * INW + 1280 + g * 128 + ch * 8);
    }
#pragma unroll
    for (int i = 0; i < 4; ++i) {
      const int c = tid + i * 512;
      ww[i] = *(const uint4*)(wsrc + (c >> 4) * 128 + (c & 15) * 8);
    }
#pragma unroll
    for (int i = 0; i < 5; ++i) {
      const int c = tid + i * 512;
      if (c < 144 * 16) *(uint4*)(U + (c >> 4) * 272 + (c & 15) * 16) = uu[i];
    }
#pragma unroll
    for (int i = 0; i < 4; ++i) {
      const int c = tid + i * 512;
      *(uint4*)(W + (c >> 4) * 272 + (c & 15) * 16) = ww[i];
    }
  }
  const int wm = wave & 3, wn = wave >> 2;
  const size_t m = (size_t)(m0 + wm * 32 + r);
  uint2 gpv_[2][4];
  float4 ps_[2][4], pn_[2][4];
#pragma unroll
  for (int nt = 0; nt < 2; ++nt)
#pragma unroll
    for (int gq = 0; gq < 4; ++gq)
    {
      const int c_ = g * 128 + wn * 64 + nt * 32 + 8 * gq + 4 * h;
      gpv_[nt][gq] = *(const uint2*)(P + m * INW + 1792 + c_);
      ps_[nt][gq] = *(const float4*)(p.pool_scale + l * 512 + c_);
      pn_[nt][gq] = *(const float4*)(p.pool_norm + l * 512 + c_);
    }
  __syncthreads();
  switch (g) {
    case 0: pool_window<1>(U, Pm, t0, L, tid); break;
    case 1: pool_window<2>(U, Pm, t0, L, tid); break;
    case 2: pool_window<4>(U, Pm, t0, L, tid); break;
    default: pool_window<8>(U, Pm, t0, L, tid); break;
  }
  __syncthreads();
  f32x16 acc[2];
#pragma unroll
  for (int i = 0; i < 16; ++i) { acc[0][i] = 0.f; acc[1][i] = 0.f; }
  const unsigned char* wa = W + (wn * 64 + r) * 272 + h * 16;
  const unsigned char* pb = Pm + (wm * 32 + r) * 272 + h * 16;
#pragma unroll
  for (int ks = 0; ks < 8; ++ks) {
    const bf16x8 bq = *(const bf16x8*)(pb + ks * 32);
    const bf16x8 a0 = *(const bf16x8*)(wa + ks * 32);
    const bf16x8 a1 = *(const bf16x8*)(wa + 32 * 272 + ks * 32);
    acc[0] = MFMA32(a0, bq, acc[0]);
    acc[1] = MFMA32(a1, bq, acc[1]);
  }
  float ssq = 0.f;
#pragma unroll
  for (int nt = 0; nt < 2; ++nt)
#pragma unroll
    for (int gq = 0; gq < 4; ++gq) {
      const int c = g * 128 + wn * 64 + nt * 32 + 8 * gq + 4 * h;
      const float4 ps = ps_[nt][gq];
      const float4 pn = pn_[nt][gq];
      const uint2 gpv = gpv_[nt][gq];
      const float o0 = acc[nt][4 * gq + 0] * ps.x, o1 = acc[nt][4 * gq + 1] * ps.y, o2 = acc[nt][4 * gq + 2] * ps.z,
                  o3 = acc[nt][4 * gq + 3] * ps.w;
      ssq += (o0 * o0 + o1 * o1) + (o2 * o2 + o3 * o3);
      uint2 ov;
      ov.x = pack2(o0 * pn.x * silu_f(bflo(gpv.x)), o1 * pn.y * silu_f(bfhi(gpv.x)));
      ov.y = pack2(o2 * pn.z * silu_f(bflo(gpv.y)), o3 * pn.w * silu_f(bfhi(gpv.y)));
      *(uint2*)(am + m * 1024 + 512 + c) = ov;
    }
  ssq += __shfl_xor(ssq, 32);
  if (h == 0) ssp[m * 8 + g * 2 + wn] = ssq;
}

DI void transpose_item(const float* __restrict__ src, ushort_t* __restrict__ dst, int R, int C, int r0, int c0,
                       unsigned char* sm, int t256) {
  float* T = (float*)sm;
  const int rr = t256 >> 4, cc4 = (t256 & 15) * 4;
#pragma unroll
  for (int i = 0; i < 4; ++i) {
    const int row = rr + 16 * i;
    const float4 v = *(const float4*)(src + (size_t)(r0 + row) * C + c0 + cc4);
    T[row * 65 + cc4 + 0] = v.x;
    T[row * 65 + cc4 + 1] = v.y;
    T[row * 65 + cc4 + 2] = v.z;
    T[row * 65 + cc4 + 3] = v.w;
  }
  __syncthreads();
  const int c = t256 >> 2, rseg = (t256 & 3) * 16;
  uint4 o0, o1;
  o0.x = pack2(T[(rseg + 0) * 65 + c], T[(rseg + 1) * 65 + c]);
  o0.y = pack2(T[(rseg + 2) * 65 + c], T[(rseg + 3) * 65 + c]);
  o0.z = pack2(T[(rseg + 4) * 65 + c], T[(rseg + 5) * 65 + c]);
  o0.w = pack2(T[(rseg + 6) * 65 + c], T[(rseg + 7) * 65 + c]);
  o1.x = pack2(T[(rseg + 8) * 65 + c], T[(rseg + 9) * 65 + c]);
  o1.y = pack2(T[(rseg + 10) * 65 + c], T[(rseg + 11) * 65 + c]);
  o1.z = pack2(T[(rseg + 12) * 65 + c], T[(rseg + 13) * 65 + c]);
  o1.w = pack2(T[(rseg + 14) * 65 + c], T[(rseg + 15) * 65 + c]);
  ushort_t* d = dst + (size_t)(c0 + c) * R + r0 + rseg;
  *(uint4*)d = o0;
  *(uint4*)(d + 8) = o1;
}


DI void transpose_strip(const float* __restrict__ src, ushort_t* __restrict__ dst, int R, int C, int r0, int c0,
                        unsigned char* sm, int t256) {
  float* T = (float*)sm;
  const int rr = t256 >> 6, cc4 = (t256 & 63) * 4;
  float4 v[16];
#pragma unroll
  for (int i = 0; i < 16; ++i) v[i] = *(const float4*)(src + (size_t)(r0 + rr + 4 * i) * C + c0 + cc4);
#pragma unroll
  for (int i = 0; i < 16; ++i) {
    float* t = T + (rr + 4 * i) * 257 + cc4;
    t[0] = v[i].x; t[1] = v[i].y; t[2] = v[i].z; t[3] = v[i].w;
  }
  __syncthreads();
  ushort_t* d = dst + (size_t)(c0 + t256) * R + r0;
#pragma unroll
  for (int g = 0; g < 8; ++g) {
    uint4 o;
    o.x = pack2(T[(8 * g + 0) * 257 + t256], T[(8 * g + 1) * 257 + t256]);
    o.y = pack2(T[(8 * g + 2) * 257 + t256], T[(8 * g + 3) * 257 + t256]);
    o.z = pack2(T[(8 * g + 4) * 257 + t256], T[(8 * g + 5) * 257 + t256]);
    o.w = pack2(T[(8 * g + 6) * 257 + t256], T[(8 * g + 7) * 257 + t256]);
    *(uint4*)(d + 8 * g) = o;
  }
}

DI void weight_pair_item(const Params& p, int L, int it, unsigned char* sm, const int wave_s) {
  const int tid = TIDX;
  const int half = tid >> 8, t256 = tid & 255;
  if (it < 72) {
    const int it2 = it * 2 + half;
    const int rt = it2 / 9, ct = it2 % 9;
    transpose_strip(p.w_in + (size_t)L * 1024 * 2304, (ushort_t*)(p.ws + OFF_WTIN) + (size_t)L * 2304 * 1024, 1024, 2304,
                    rt * 64, ct * 256, sm + half * 65792, t256);
  } else if (it < 72 + 32) {
    const int it2 = (it - 72) * 2 + half;
    const int rt = it2 >> 2, ct = it2 & 3;
    transpose_strip(p.w_out + (size_t)L * 1024 * 1024, (ushort_t*)(p.ws + OFF_WTOUT) + (size_t)L * 1024 * 1024, 1024, 1024,
                    rt * 64, ct * 256, sm + half * 65792, t256);
  } else {
    const int it2 = (it - 72 - 32) * 2 + half;
    const int mat = L * 4 + (it2 >> 2), rt = (it2 >> 1) & 1, ct = it2 & 1;
    transpose_item(p.w_pool + (size_t)mat * 128 * 128, (ushort_t*)(p.ws + OFF_WTPOOL) + (size_t)mat * 128 * 128, 128, 128,
                   rt * 64, ct * 64, sm + half * 16640, t256);
  }
}

DI void mod_item(const Params& p, int L, int cg64, unsigned char* sm, const int wave_s) {
  const int tid = TIDX, wave = tid >> 6, lane = tid & 63;
  float* sv = (float*)sm;
  float* red = (float*)(sm + 20480);
  for (int idx = tid; idx < 5120; idx += 512) {
    const int rr = idx >> 10, k = idx & 1023;
    const float cv = rr == 0 ? p.c_ctx[k] : p.c[(rr - 1) * 1024 + k];
    sv[idx] = silu_f(cv);
  }
  __syncthreads();
  const int j = cg64 * 64 + lane;
  const float* wp = p.w_ada + ((size_t)L * 1024 + wave * 128) * 3072 + j;
  const float* s0 = sv + wave * 128;
  float a0 = 0.f, a1 = 0.f, a2 = 0.f, a3 = 0.f, a4 = 0.f;
#pragma unroll 8
  for (int kk = 0; kk < 128; ++kk) {
    const float w = wp[(size_t)kk * 3072];
    a0 += s0[kk] * w;
    a1 += s0[1024 + kk] * w;
    a2 += s0[2048 + kk] * w;
    a3 += s0[3072 + kk] * w;
    a4 += s0[4096 + kk] * w;
  }
  float* rd = red + (wave * 5) * 64 + lane;
  rd[0] = a0; rd[64] = a1; rd[128] = a2; rd[192] = a3; rd[256] = a4;
  __syncthreads();
  if (tid < 320) {
    const int rr = tid >> 6, c = tid & 63;
    float s = p.b_ada[L * 3072 + cg64 * 64 + c];
#pragma unroll
    for (int w = 0; w < 8; ++w) s += red[(w * 5 + rr) * 64 + c];
    ((float*)(p.ws + OFF_MOD))[(size_t)(L * 5 + rr) * 3072 + cg64 * 64 + c] = s;
  }
}

DI void sw_item(const Params& p, int L, int it, unsigned char* sm, const int wave_s) {
  const int tid = TIDX, half = tid >> 8, t256 = tid & 255;
  const int kc = it / 5, cgp = (it % 5) * 2 + half;
  const float* mod = (const float*)(p.ws + OFF_MOD);
  float* sh = (float*)sm + half * 320;
  for (int idx = t256; idx < 320; idx += 256) {
    const int rr = idx >> 6, kk = idx & 63;
    sh[idx] = mod[(size_t)(L * 5 + rr) * 3072 + kc * 64 + kk];
  }
  __syncthreads();
  if (cgp < 9) {
    const int n = cgp * 256 + t256;
    float a0 = 0.f, a1 = 0.f, a2 = 0.f, a3 = 0.f, a4 = 0.f;
    const float* wp = p.w_in + ((size_t)L * 1024 + kc * 64) * 2304 + n;
#pragma unroll 8
    for (int kk = 0; kk < 64; ++kk) {
      const float w = wp[(size_t)kk * 2304];
      a0 += sh[kk] * w;
      a1 += sh[64 + kk] * w;
      a2 += sh[128 + kk] * w;
      a3 += sh[192 + kk] * w;
      a4 += sh[256 + kk] * w;
    }
    float* sp = (float*)(p.ws + OFF_SWPART) + ((size_t)(kc * 4 + L) * 5) * 2304 + n;
    sp[0] = a0; sp[2304] = a1; sp[2 * 2304] = a2; sp[3 * 2304] = a3; sp[4 * 2304] = a4;
  }
}

DI void sincos_d(double a, double& sn, double& cs) {
  const double twopi = 6.283185307179586476925;
  const double n = rint(a / twopi);
  const double x = a - n * twopi;
  const double x2 = x * x;
  double ts = x, tc = 1.0, s = x, c = 1.0;
#pragma unroll 1
  for (int k = 1; k <= 16; ++k) {
    tc = -tc * x2 / (double)((2 * k - 1) * (2 * k));
    ts = -ts * x2 / (double)((2 * k) * (2 * k + 1));
    c += tc;
    s += ts;
  }
  sn = s;
  cs = c;
}

__global__ void __launch_bounds__(512, 2) fwd_megakernel(Params p) {
  cg::grid_group grid = cg::this_grid();
  __shared__ __attribute__((aligned(16))) unsigned char sm[SMEM_TOTAL];
  uint4& xb_words = *(uint4*)(sm + L_XB);
  const int nblk = gridDim.x;
  const int wave_s = __builtin_amdgcn_readfirstlane((int)(threadIdx.x >> 6));
  if (p.ws == nullptr) grid.sync();
  const bool is_t0 = (TIDX == 0);
  if (is_t0) xb_words = make_uint4(0u, 0u, 0u, 0u);
  __syncthreads();
  (void)xcd_barrier_post((unsigned*)(p.ws + OFF_BAR), (volatile LAS unsigned*)&xb_words, is_t0);
#define GRID_SYNC()                                            \
  do {                                                         \
    XcdBarrier xb_;                                            \
    xb_.bar = (unsigned*)(p.ws + opq_o(OFF_BAR));              \
    xb_.x = xb_xcc_id();                                       \
    xb_.st = (volatile LAS unsigned*)&xb_words;                \
    xcd_barrier(xb_, TIDX == 0);                               \
  } while (0)

  {
    const int tid = TIDX;
    constexpr int TOTAL = 4 * N_TPAIR + 4 * 48 + 1;
    for (int item = blockIdx.x; item < TOTAL; item += nblk) {
      __syncthreads();
      if (item < 4 * N_TPAIR) {
        weight_pair_item(p, item / N_TPAIR, item % N_TPAIR, sm, wave_s);
      } else if (item < 4 * N_TPAIR + 192) {
        mod_item(p, (item - 4 * N_TPAIR) / 48, (item - 4 * N_TPAIR) % 48, sm, wave_s);
      } else {
        float2* rc = (float2*)(p.ws + OFF_ROPE);
        for (int idx = tid; idx < 1024; idx += 512) {
          const int pos = idx >> 4, fi = idx & 15;
          const float inv = __builtin_amdgcn_exp2f(-(float)fi * (1.f / 16.f) * 13.287712379549449f);
          const float ang = (float)pos * inv;
          double sn, cs;
          sincos_d((double)ang, sn, cs);
          rc[idx] = make_float2((float)cs, (float)sn);
        }
      }
    }
  }
  GRID_SYNC();
  {
    for (int item = blockIdx.x; item < 4 * N_SWITEM; item += nblk) {
      __syncthreads();
      sw_item(p, item / N_SWITEM, item % N_SWITEM, sm, wave_s);
    }
    const float* mod = (const float*)(p.ws + OFF_MOD);
    ushort_t* xg = (ushort_t*)(p.ws + OFF_XG);
    float* rowss = (float*)(p.ws + OFF_ROWSS);
    const int tidr = TIDX, lane = tidr & 63;
    const int rstride = nblk * 8;
    for (int row0 = blockIdx.x * 8 + (tidr >> 6); row0 < NTOK; row0 += 6 * rstride) {
      float4 v[6][4];
      bool ok[6];
#pragma unroll
      for (int u = 0; u < 6; ++u) {
        const int row = row0 + u * rstride;
        ok[u] = row < NTOK;
        const int rw = ok[u] ? row : row0;
        const float* src = rw < NCTX ? p.x_prompt + (size_t)rw * 1024 : p.x_sample + (size_t)(rw - NCTX) * 1024;
#pragma unroll
        for (int i = 0; i < 4; ++i) v[u][i] = *(const float4*)(src + lane * 4 + 256 * i);
      }
#pragma unroll
      for (int u = 0; u < 6; ++u) {
        const int row = row0 + u * rstride;
        if (!ok[u]) continue;
        const float* scl = mod + (size_t)mod_row(row) * 3072 + 1024;
        float ss = 0.f;
#pragma unroll
        for (int i = 0; i < 4; ++i) {
          const int n = lane * 4 + 256 * i;
          const float4 x4 = v[u][i];
          const float4 sc = *(const float4*)(scl + n);
          const float4 w4 = *(const float4*)(p.norm_w + n);
          ss += (x4.x * x4.x + x4.y * x4.y) + (x4.z * x4.z + x4.w * x4.w);
          uint2 o;
          o.x = pack2(x4.x * (w4.x * (1.f + sc.x)), x4.y * (w4.y * (1.f + sc.y)));
          o.y = pack2(x4.z * (w4.z * (1.f + sc.z)), x4.w * (w4.w * (1.f + sc.w)));
          *(uint2*)(xg + (size_t)row * 1024 + n) = o;
        }
#pragma unroll
        for (int off = 32; off >= 1; off >>= 1) ss += __shfl_xor(ss, off);
        if (lane < 8) rowss[(size_t)row * 8 + lane] = lane == 0 ? ss : 0.f;
      }
    }
  }
  GRID_SYNC();
#pragma unroll 1
  for (int l = 0; l < 4; ++l) {
    phase_inproj(p, l, sm, wave_s);
    GRID_SYNC();
    if (nblk == 256) {
      const int xq = blockIdx.x & 7, rq = blockIdx.x >> 3;
      __syncthreads();
      attn_item(p, l, (rq >> 3) * 64 + ((rq >> 2) & 1) * 32 + 4 * xq + (rq & 3), sm, wave_s);
      __syncthreads();
      if (rq < 16) {
        attn_item(p, l, 256 + (xq + 8 * (rq >> 3)) * 8 + ((rq >> 2) & 1) * 4 + (rq & 3), sm, wave_s);
      } else {
        const int e = rq - 16;
        pool_item(p, l, (2 * (xq + 8 * (e >> 3)) + ((e >> 2) & 1)) * 4 + (e & 3), sm, wave_s);
      }
      __syncthreads();
      {
        const int e = 16 + rq;
        pool_item(p, l, (2 * (xq + 8 * (e >> 3)) + ((e >> 2) & 1)) * 4 + (e & 3), sm, wave_s);
      }
    } else {
      for (int item = blockIdx.x; item < 384 + 384; item += nblk) {
        __syncthreads();
        if (item < 384) attn_item(p, l, item, sm, wave_s);
        else pool_item(p, l, item - 384, sm, wave_s);
      }
    }
    GRID_SYNC();
    phase_outproj(p, l, sm, wave_s);
    GRID_SYNC();
  }
  {
    const float* xws = (const float*)(p.ws + OFF_X);
    const float* rowss = (const float*)(p.ws + OFF_ROWSS);
    const int tidr = TIDX, lane = tidr & 63;
    const int rstride = nblk * 8;
    for (int row0 = blockIdx.x * 8 + (tidr >> 6); row0 < NTOK; row0 += 6 * rstride) {
      float4 v[6][4];
      float rr[6];
#pragma unroll
      for (int u = 0; u < 6; ++u) {
        const int row = (row0 + u * rstride) < NTOK ? (row0 + u * rstride) : row0;
        const float4* rs = (const float4*)(rowss + (size_t)row * 8);
        const float4 s0 = rs[0], s1 = rs[1];
        rr[u] = rsqrtf((((s0.x + s0.y) + (s0.z + s0.w)) + ((s1.x + s1.y) + (s1.z + s1.w))) * (1.f / 1024.f) + EPS);
#pragma unroll
        for (int i = 0; i < 4; ++i) v[u][i] = *(const float4*)(xws + (size_t)row * 1024 + lane * 4 + 256 * i);
      }
#pragma unroll
      for (int u = 0; u < 6; ++u) {
        const int row = row0 + u * rstride;
        if (row >= NTOK) continue;
#pragma unroll
        for (int i = 0; i < 4; ++i) {
          const int n = lane * 4 + 256 * i;
          const float4 w4 = *(const float4*)(p.final_norm + n);
          const float4 x4 = v[u][i];
          *(float4*)(p.out + (size_t)row * 1024 + n) =
              make_float4(x4.x * rr[u] * w4.x, x4.y * rr[u] * w4.y, x4.z * rr[u] * w4.z, x4.w * rr[u] * w4.w);
        }
      }
    }
  }
}

extern "C" void kernel_launch(void* const* d_in, const int* in_sizes, int n_in, void* d_out, int out_size, void* d_ws,
                              size_t ws_size, hipStream_t stream) {
  static int grid_blocks = 0;
  if (!grid_blocks) {
    int dev = 0, cus = 0, per_cu = 0;
    (void)hipGetDevice(&dev);
    (void)hipDeviceGetAttribute(&cus, hipDeviceAttributeMultiprocessorCount, dev);
    (void)hipOccupancyMaxActiveBlocksPerMultiprocessor(&per_cu, fwd_megakernel, 512, 0);
    if (per_cu < 1) fprintf(stderr, "occupancy query reports %d blocks per CU\n", per_cu);
    grid_blocks = cus;
  }
  Params p{};
  p.x_prompt = (const float*)d_in[0];
  p.x_sample = (const float*)d_in[1];
  p.cache_k = (const float*)d_in[2];
  p.cache_v = (const float*)d_in[3];
  p.c = (const float*)d_in[4];
  p.c_ctx = (const float*)d_in[5];
  p.norm_w = (const float*)d_in[6];
  p.w_ada = (const float*)d_in[7];
  p.b_ada = (const float*)d_in[8];
  p.w_in = (const float*)d_in[9];
  p.sink = (const float*)d_in[10];
  p.attn_norm = (const float*)d_in[11];
  p.pool_norm = (const float*)d_in[12];
  p.w_pool = (const float*)d_in[13];
  p.pool_scale = (const float*)d_in[14];
  p.w_out = (const float*)d_in[15];
  p.final_norm = (const float*)d_in[16];
  p.out = (float*)d_out;
  p.ws = (unsigned char*)d_ws;
  (void)hipMemsetAsync((unsigned char*)d_ws + OFF_BAR, 0, XCD_BAR_WORDS * 4, stream);
  void* args[] = {&p};
  hipError_t e = hipLaunchCooperativeKernel((void*)fwd_megakernel, dim3(grid_blocks), dim3(512), args, 0, stream);
  if (e != hipSuccess) fprintf(stderr, "cooperative launch failed: %s (grid %d)\n", hipGetErrorString(e), grid_blocks);
}
```

```cpp
#include <hip/hip_runtime.h>
#include <hip/hip_cooperative_groups.h>
#include <cstdio>
namespace cg = cooperative_groups;

typedef __attribute__((ext_vector_type(8))) short bf16x8;
typedef __attribute__((ext_vector_type(4))) short s16x4;
typedef __attribute__((ext_vector_type(16))) float f32x16;
typedef __attribute__((ext_vector_type(4))) float f32x4;
typedef __bf16 bf2_t __attribute__((ext_vector_type(2)));
typedef float f2_t __attribute__((ext_vector_type(2)));
typedef unsigned short ushort_t;

#define DI __device__ __forceinline__
#define MFMA32(a, b, c) __builtin_amdgcn_mfma_f32_32x32x16_bf16((a), (b), (c), 0, 0, 0)

constexpr int NTOK = 12288, NCTX = 4096, DM = 1024, INW = 2304;
constexpr float EPS = 1e-6f;
constexpr float LOG2E = 1.4426950408889634f;

constexpr size_t OFF_WTIN = 0;
constexpr size_t OFF_WTOUT = OFF_WTIN + 4ull * 2304 * 1024 * 2;
constexpr size_t OFF_WTPOOL = OFF_WTOUT + 4ull * 1024 * 1024 * 2;
constexpr size_t OFF_MODPART = OFF_WTPOOL + 4ull * 4 * 128 * 128 * 2;
constexpr size_t OFF_MOD = OFF_MODPART + 16ull * 4 * 5 * 3072 * 4;
constexpr size_t OFF_SWPART = OFF_MOD + 4ull * 5 * 3072 * 4;
constexpr size_t OFF_SW = OFF_SWPART + 16ull * 4 * 5 * 2304 * 4;
constexpr size_t OFF_ROPE = OFF_SW + 4ull * 5 * 2304 * 4;
constexpr size_t OFF_X = OFF_ROPE + 64 * 16 * 8;
constexpr size_t OFF_XG = OFF_X + 12288ull * 1024 * 4;
constexpr size_t OFF_P = OFF_XG + 12288ull * 1024 * 2;
constexpr size_t OFF_AM = OFF_P + 12288ull * 2304 * 2;
constexpr size_t OFF_ROWSS = OFF_AM + 12288ull * 1024 * 2;
constexpr size_t OFF_SSA = OFF_ROWSS + 12288ull * 16 * 4;
constexpr size_t OFF_SSP = OFF_SSA + 12288ull * 8 * 4;
constexpr size_t OFF_BAR = OFF_SSP + 12288ull * 8 * 4;
constexpr size_t OFF_X1 = OFF_BAR + 16384;

constexpr int SMEM_BYTES = 131072;
constexpr int L_RATIO = SMEM_BYTES;
constexpr int L_RP = L_RATIO + 1024;
constexpr int L_GG = L_RP + 1024;
constexpr int L_SW = L_GG + 2048;
constexpr int L_RR = L_SW + 1024;
constexpr int L_ROPE = L_RR + 1024;
constexpr int L_XB = L_ROPE + 8192;
constexpr int SMEM_TOTAL = L_XB + 16;

struct Params {
  const float *x_prompt, *x_sample, *cache_k, *cache_v, *c, *c_ctx, *norm_w, *w_ada, *b_ada, *w_in, *sink, *attn_norm,
      *pool_norm, *w_pool, *pool_scale, *w_out, *final_norm;
  float* out;
  unsigned char* ws;
};

DI unsigned pack2(float a, float b) {
  f2_t v = {a, b};
  return __builtin_bit_cast(unsigned, __builtin_convertvector(v, bf2_t));
}
DI float bflo(unsigned u) { return __uint_as_float(u << 16); }
DI float bfhi(unsigned u) { return __uint_as_float(u & 0xffff0000u); }
DI float silu_f(float x) { return x * __builtin_amdgcn_rcpf(1.f + __expf(-x)); }
DI int opq(int x) { asm volatile("" : "+v"(x)); return x; }
DI int lane_id_v() {
  int r;
  asm volatile("v_mbcnt_lo_u32_b32 %0, -1, 0\n\tv_mbcnt_hi_u32_b32 %0, -1, %0" : "=v"(r));
  return r;
}
#define TIDX (wave_s * 64 + lane_id_v())
DI size_t opq_o(size_t o) { asm volatile("" : "+s"(o)); return o; }
DI int crow(int i, int h) { return (i & 3) + 8 * (i >> 2) + 4 * h; }


#define XB_TMO      128
#define XB_XCNT(j)  (256  + 64 * (j))
#define XB_XSUB(j)  (1280 + 64 * (j))
#define XB_XGEN(j)  (2304 + 64 * (j))
#define XB_TOP      3328
#define XB_TOPGEN   3392
#define XCD_BAR_WORDS 3456
#define XB_SPIN_CAP (1u << 18)
#define LAS __attribute__((address_space(3)))
DI unsigned xb_ld(unsigned* p) { return __hip_atomic_load(p, __ATOMIC_RELAXED, __HIP_MEMORY_SCOPE_AGENT); }
DI unsigned xb_add(unsigned* p, unsigned v) { return __hip_atomic_fetch_add(p, v, __ATOMIC_RELAXED, __HIP_MEMORY_SCOPE_AGENT); }
DI unsigned xb_xcc_id() { return (unsigned)__builtin_amdgcn_s_getreg((3 << 11) | 20) & 0xFu; }
#define XB_SPIN(cond, bar) do { unsigned _sp = 0; while (cond) { __builtin_amdgcn_s_sleep(1); \
    if ((++_sp & 255u) == 0u) { if (xb_ld(&(bar)[XB_TMO])) break; if (_sp > XB_SPIN_CAP) { atomicAdd(&(bar)[XB_TMO], 1u); break; } } } } while (0)
struct XcdBarrier { unsigned* bar; unsigned x; volatile LAS unsigned* st; };
DI XcdBarrier xcd_barrier_post(unsigned* bar, volatile LAS unsigned* st, bool is_t0) {
  XcdBarrier b; b.bar = bar; b.x = xb_xcc_id(); b.st = st;
  if (is_t0) (void)xb_add(&bar[XB_XCNT(b.x)], 1u);
  return b;
}
DI void xcd_barrier_complete(unsigned* bar, unsigned x, unsigned& nloc, unsigned& nx) {
  const unsigned G = gridDim.x * gridDim.y * gridDim.z;
  unsigned sum, cnt, mine, sp = 0u;
  for (;;) {
    sum = 0u; cnt = 0u; mine = 0u;
#pragma unroll
    for (unsigned j = 0; j < 16; ++j) { const unsigned c = xb_ld(&bar[XB_XCNT(j)]); sum += c; cnt += (c > 0u) ? 1u : 0u; mine = (j == x) ? c : mine; }
    if (sum == G) break;
    __builtin_amdgcn_s_sleep(1);
    if ((++sp & 255u) == 0u) { if (xb_ld(&bar[XB_TMO])) break; if (sp > XB_SPIN_CAP) { atomicAdd(&bar[XB_TMO], 1u); break; } }
  }
  nloc = mine > 0u ? mine : 1u; nx = cnt > 0u ? cnt : 1u;
}
DI void xcd_barrier(const XcdBarrier& b, bool is_t0) {
  asm volatile("s_waitcnt vmcnt(0)" ::: "memory");
  __syncthreads();
  if (is_t0) {
    unsigned* bar = b.bar;
    __builtin_amdgcn_s_waitcnt(0);
    unsigned nloc = b.st[0], nx = b.st[1];
    if (nloc == 0u) { xcd_barrier_complete(bar, b.x, nloc, nx); b.st[0] = nloc; b.st[1] = nx; }
    const unsigned old = xb_add(&bar[XB_XSUB(b.x)], 1u);
    const unsigned gen = old / nloc;
    if (old + 1u == (gen + 1u) * nloc) {
      __builtin_amdgcn_fence(__ATOMIC_RELEASE, "agent");
      asm volatile("s_waitcnt vmcnt(0)" ::: "memory");
      const unsigned og = xb_add(&bar[XB_TOP], 1u);
      const unsigned tg = og / nx;
      if (og + 1u == (tg + 1u) * nx) xb_add(&bar[XB_TOPGEN], 1u);
      else XB_SPIN(xb_ld(&bar[XB_TOPGEN]) == tg, bar);
      __builtin_amdgcn_fence(__ATOMIC_ACQUIRE, "agent");
      xb_add(&bar[XB_XGEN(b.x)], 1u);
      asm volatile("s_waitcnt vmcnt(0)" ::: "memory");
    } else {
      XB_SPIN(xb_ld(&bar[XB_XGEN(b.x)]) == gen, bar);
      __builtin_amdgcn_fence(__ATOMIC_ACQUIRE, "agent");
      asm volatile("s_waitcnt vmcnt(0)" ::: "memory");
    }
  }
  __syncthreads();
}


constexpr int G_HT = 128 * 64;
DI int lds_byte(int r, int c) {
  int st = (r >> 4) * 2 + (c >> 5), rr = r & 15, cc = c & 31, ob = rr * 64 + cc * 2;
  return st * 1024 + (ob ^ (((ob >> 9) & 1) << 5));
}
DI void stage_rc(int b, int& R, int& C) {
  int st = b / 1024, sb = b % 1024, swz = sb ^ (((sb >> 9) & 1) << 5);
  R = (st >> 1) * 16 + swz / 64;
  C = (st & 1) * 32 + (swz % 64) / 2;
}

template <class Mid>
DI void gemm256(const ushort_t* __restrict__ A, const ushort_t* __restrict__ Bt, f32x4 (&acc)[2][2][4][2],
                unsigned char* shm_, Mid mid, const int wave_s) {
  constexpr int K = 1024, BK = 64, HALF = 128, nt = K / BK;
  ushort_t* shm = (ushort_t*)shm_;
  const int tid = TIDX;
  const int wid = tid >> 6, lane = tid & 63, wr = wid >> 2, wc = wid & 3, fr = lane & 15, fq = lane >> 4;
  unsigned go0, go1;
  {
    int r_, c_;
    stage_rc(tid * 16, r_, c_);
    go0 = (unsigned)(r_ * K + c_) * 2u;
    stage_rc(tid * 16 + 8192, r_, c_);
    go1 = (unsigned)(r_ * K + c_) * 2u;
  }
#define SA(b, h) (shm + ((b) * 2 + (h)) * G_HT)
#define SB(b, h) (shm + (4 + (b) * 2 + (h)) * G_HT)
#define STAGE(P, BASE, br, kt)                                                                                      \
  do {                                                                                                              \
    const char* _g = (const char*)((BASE) + (size_t)(br) * K + (kt) * BK);                                          \
    __builtin_amdgcn_global_load_lds((const unsigned*)(_g + go0), (LAS unsigned*)((char*)(P) + wave_s * 1024), 16, 0, 0); \
    __builtin_amdgcn_global_load_lds((const unsigned*)(_g + go1), (LAS unsigned*)((char*)(P) + wave_s * 1024 + 8192), 16, 0, 0); \
  } while (0)
#define LDA(dst, b, h)                                                                                              \
  _Pragma("unroll") for (int m = 0; m < 4; ++m) _Pragma("unroll") for (int k = 0; k < 2; ++k)                       \
      dst[m][k] = *reinterpret_cast<const bf16x8*>((char*)SA(b, h) + lds_byte(wr * 64 + m * 16 + fr, k * 32 + fq * 8))
#define LDB(dst, b, h)                                                                                              \
  _Pragma("unroll") for (int n = 0; n < 2; ++n) _Pragma("unroll") for (int k = 0; k < 2; ++k)                       \
      dst[n][k] = *reinterpret_cast<const bf16x8*>((char*)SB(b, h) + lds_byte(wc * 32 + n * 16 + fr, k * 32 + fq * 8))
#define MMA(ai, bj, At_, Bt_)                                                                                       \
  do {                                                                                                              \
    __builtin_amdgcn_s_setprio(1);                                                                                  \
    _Pragma("unroll") for (int m = 0; m < 4; ++m) _Pragma("unroll") for (int n = 0; n < 2; ++n)                     \
        _Pragma("unroll") for (int k = 0; k < 2; ++k) acc[ai][bj][m][n] =                                           \
            __builtin_amdgcn_mfma_f32_16x16x32_bf16(At_[m][k], Bt_[n][k], acc[ai][bj][m][n], 0, 0, 0);              \
    __builtin_amdgcn_s_setprio(0);                                                                                  \
  } while (0)
#define WAIT_V(n) asm volatile("s_waitcnt vmcnt(" #n ")" ::: "memory")
#define WAIT_L(n) asm volatile("s_waitcnt lgkmcnt(" #n ")" ::: "memory")
#define BAR __builtin_amdgcn_s_barrier()
#define SCHED __builtin_amdgcn_sched_barrier(0)
  bf16x8 At[4][2], B0[2][2], B1[2][2];
  STAGE(SB(0, 0), Bt, 0, 0); STAGE(SA(0, 0), A, 0, 0);
  STAGE(SB(0, 1), Bt, HALF, 0); STAGE(SA(0, 1), A, HALF, 0);
  if (wr == 1) BAR;
  WAIT_V(4); BAR;
  STAGE(SB(1, 0), Bt, 0, 1); STAGE(SA(1, 0), A, 0, 1); STAGE(SB(1, 1), Bt, HALF, 1);
  WAIT_V(6); BAR;
#pragma unroll 1
  for (int t = 0; t < nt - 2; t += 2) {
    if (t == nt / 2) mid(acc);
    LDB(B0, 0, 0); SCHED; LDA(At, 0, 0); STAGE(SA(1, 1), A, HALF, t + 1);
    WAIT_L(8); BAR; WAIT_L(0); MMA(0, 0, At, B0); BAR; SCHED;
    LDB(B1, 0, 1); STAGE(SB(0, 0), Bt, 0, t + 2);
    BAR; WAIT_L(0); MMA(0, 1, At, B1); BAR;
    LDA(At, 0, 1); STAGE(SA(0, 0), A, 0, t + 2);
    BAR; WAIT_L(0); MMA(1, 0, At, B0); BAR; SCHED;
    STAGE(SB(0, 1), Bt, HALF, t + 2);
    WAIT_V(6); BAR; MMA(1, 1, At, B1); BAR;
    LDB(B0, 1, 0); SCHED; LDA(At, 1, 0); STAGE(SA(0, 1), A, HALF, t + 2);
    WAIT_L(8); BAR; WAIT_L(0); MMA(0, 0, At, B0); BAR; SCHED;
    LDB(B1, 1, 1); STAGE(SB(1, 0), Bt, 0, t + 3);
    BAR; WAIT_L(0); MMA(0, 1, At, B1); BAR;
    LDA(At, 1, 1); STAGE(SA(1, 0), A, 0, t + 3);
    BAR; WAIT_L(0); MMA(1, 0, At, B0); BAR; SCHED;
    STAGE(SB(1, 1), Bt, HALF, t + 3);
    WAIT_V(6); BAR; MMA(1, 1, At, B1); BAR;
  }
  {
    LDB(B0, 0, 0); LDA(At, 0, 0); STAGE(SA(1, 1), A, HALF, nt - 1);
    BAR; WAIT_L(0); MMA(0, 0, At, B0); BAR;
    LDB(B1, 0, 1); BAR; WAIT_L(0); MMA(0, 1, At, B1); BAR;
    LDA(At, 0, 1); WAIT_V(4); BAR; WAIT_L(0); MMA(1, 0, At, B0); MMA(1, 1, At, B1); BAR;
  }
  {
    LDB(B0, 1, 0); LDA(At, 1, 0); WAIT_V(2); BAR; WAIT_L(0); MMA(0, 0, At, B0); BAR;
    LDB(B1, 1, 1); WAIT_V(0); BAR; WAIT_L(0); MMA(0, 1, At, B1); BAR;
    LDA(At, 1, 1); BAR; WAIT_L(0); MMA(1, 0, At, B0); MMA(1, 1, At, B1); BAR;
  }
  if (wr == 0) BAR;
#undef SA
#undef SB
#undef STAGE
#undef LDA
#undef LDB
#undef MMA
}

constexpr int N_TPAIR = 72 + 32 + 8;
DI void weight_pair_item(const Params& p, int L, int it, unsigned char* sm, const int wave_s);
DI void sw_item(const Params& p, int L, int it, unsigned char* sm, const int wave_s);
constexpr int N_SWITEM = 16 * 5;
DI int mod_row(int m0) { return m0 < NCTX ? 0 : 1 + ((m0 - NCTX) >> 11); }


DI void phase_inproj(const Params& p, int l, unsigned char* sm, const int wave_s) {
  const ushort_t* WtIn = (const ushort_t*)(p.ws + opq_o(OFF_WTIN)) + (size_t)l * 2304 * 1024;
  const ushort_t* xg = (const ushort_t*)(p.ws + opq_o(OFF_XG));
  ushort_t* P = (ushort_t*)(p.ws + opq_o(OFF_P));
  const float* rowss = (const float*)(p.ws + opq_o(OFF_ROWSS));
  const float* swpart = (const float*)(p.ws + opq_o(OFF_SWPART));
  const float2* ropecs = (const float2*)(p.ws + opq_o(OFF_ROPE));
  {
    const int tid0 = TIDX;
    ((uint4*)(sm + L_ROPE))[tid0] = ((const uint4*)ropecs)[tid0];
  }
  for (int t = blockIdx.x; t < 9 * 48; t += gridDim.x) {
    const int pn = (t & 7) + 8 * ((t >> 3) / 9), pm = (t >> 3) % 9;
    const int brow = pm * 256, bcol = pn * 256;
    const bool lat = bcol >= NCTX;
    const int bidx = mod_row(bcol);
    f32x4 acc[2][2][4][2];
#pragma unroll
    for (int a = 0; a < 2; ++a)
#pragma unroll
      for (int b = 0; b < 2; ++b)
#pragma unroll
        for (int m = 0; m < 4; ++m)
#pragma unroll
          for (int n = 0; n < 2; ++n) acc[a][b][m][n] = (f32x4){0.f, 0.f, 0.f, 0.f};
    __syncthreads();
    {
      const int tid1 = TIDX;
      if (tid1 < 256) {
        const float* sp_ = swpart + (size_t)(l * 5 + bidx) * 2304 + brow + tid1;
        float s = 0.f;
#pragma unroll
        for (int kc = 0; kc < 16; ++kc) s += sp_[(size_t)kc * 46080];
        ((float*)(sm + L_SW))[tid1] = s;
      } else {
        const int tl = tid1 - 256;
        const float4* rs = (const float4*)(rowss + (size_t)(bcol + tl) * 8);
        const float4 s0 = rs[0], s1 = rs[1];
        const float ss = ((s0.x + s0.y) + (s0.z + s0.w)) + ((s1.x + s1.y) + (s1.z + s1.w));
        ((float*)(sm + L_RR))[tl] = rsqrtf(ss * (1.f / 1024.f) + EPS);
      }
    }
    gemm256(WtIn + (size_t)brow * 1024, xg + (size_t)bcol * 1024, acc, sm, [](f32x4(&)[2][2][4][2]) {}, wave_s);
    const int tid2 = TIDX, wid2 = tid2 >> 6, lane2 = tid2 & 63;
    const int wr = wid2 >> 2, wc = wid2 & 3, fr = lane2 & 15, fq = lane2 >> 4;
    const float* swt = (const float*)(sm + L_SW);
    const float* rrt = (const float*)(sm + L_RR);
    const float2* ropeL = (const float2*)(sm + L_ROPE);
#pragma unroll
    for (int bj = 0; bj < 2; ++bj)
#pragma unroll
      for (int n = 0; n < 2; ++n) {
        const int tloc = bj * 128 + wc * 32 + n * 16 + fr;
        const int tk = bcol + tloc;
        const float rr = rrt[tloc];
        const int tpos = (tk - NCTX) & 2047;
#pragma unroll
        for (int ai = 0; ai < 2; ++ai) {
          const int floc = ai * 128 + wr * 64;
          const int f0 = brow + floc;
          float v[4][4];
#pragma unroll
          for (int m = 0; m < 4; ++m) {
            const float4 sv = *(const float4*)(swt + floc + m * 16 + fq * 4);
            v[m][0] = acc[ai][bj][m][n][0] * rr + sv.x;
            v[m][1] = acc[ai][bj][m][n][1] * rr + sv.y;
            v[m][2] = acc[ai][bj][m][n][2] * rr + sv.z;
            v[m][3] = acc[ai][bj][m][n][3] * rr + sv.w;
          }
          if (lat && f0 < 640) {
#pragma unroll
            for (int hlf = 0; hlf < 2; ++hlf) {
              const int pos = hlf == 0 ? (tpos >> 6) : (tpos & 63);
              const float4* cp = (const float4*)(ropeL + pos * 16 + fq * 4);
              const float4 c01 = cp[0], c23 = cp[1];
              const float cs_[4] = {c01.x, c01.z, c23.x, c23.z};
              const float sn_[4] = {c01.y, c01.w, c23.y, c23.w};
#pragma unroll
              for (int e = 0; e < 4; ++e) {
                const float x1 = v[2 * hlf][e], x2 = v[2 * hlf + 1][e];
                v[2 * hlf][e] = x1 * cs_[e] - x2 * sn_[e];
                v[2 * hlf + 1][e] = x2 * cs_[e] + x1 * sn_[e];
              }
            }
          }
          const float qs = f0 < 512 ? 0.125f * LOG2E : 1.f;
#pragma unroll
          for (int m = 0; m < 4; ++m) {
            uint2 o;
            o.x = pack2(v[m][0] * qs, v[m][1] * qs);
            o.y = pack2(v[m][2] * qs, v[m][3] * qs);
            *(uint2*)(P + (size_t)tk * INW + f0 + m * 16 + fq * 4) = o;
          }
          const int f128 = f0 >> 7;
          if (!lat && (f128 == 4 || f128 == 5)) {
            const int b = tk >> 8, s = tk & 255;
            float* dst = p.out + (size_t)12582912 + (f128 == 5 ? (size_t)2097152 : 0) +
                         ((size_t)((b * 4 + l) * 256 + s)) * 128 + (f0 & 127);
#pragma unroll
            for (int m = 0; m < 4; ++m)
              *(float4*)(dst + m * 16 + fq * 4) = make_float4(v[m][0], v[m][1], v[m][2], v[m][3]);
          }
        }
      }
  }
}

DI void phase_outproj(const Params& p, int l, unsigned char* sm, const int wave_s) {
  const ushort_t* WtOut = (const ushort_t*)(p.ws + opq_o(OFF_WTOUT)) + (size_t)l * 1024 * 1024;
  const ushort_t* am = (const ushort_t*)(p.ws + opq_o(OFF_AM));
  ushort_t* xg = (ushort_t*)(p.ws + opq_o(OFF_XG));
  float* xws = (float*)(p.ws + opq_o(OFF_X));
  const float* xprev = xws;
  float* rowss = (float*)(p.ws + opq_o(OFF_ROWSS));
  const float* ssa = (const float*)(p.ws + opq_o(OFF_SSA));
  const float* ssp = (const float*)(p.ws + opq_o(OFF_SSP));
  const float* mod = (const float*)(p.ws + opq_o(OFF_MOD));
  for (int t = blockIdx.x; t < 4 * 48; t += gridDim.x) {
    const int pn = (t & 7) + 8 * ((t >> 3) >> 2), pm = (t >> 3) & 3;
    const int brow = pm * 256, bcol = pn * 256;
    const int bidx = mod_row(bcol);
    f32x4 acc[2][2][4][2];
#pragma unroll
    for (int a = 0; a < 2; ++a)
#pragma unroll
      for (int b = 0; b < 2; ++b)
#pragma unroll
        for (int m = 0; m < 4; ++m)
#pragma unroll
          for (int n = 0; n < 2; ++n) acc[a][b][m][n] = (f32x4){0.f, 0.f, 0.f, 0.f};
    __syncthreads();
    {
      const int tid1 = TIDX;
      if (tid1 < 256) {
        const int tk = bcol + tid1;
        const float4* pa = (const float4*)(ssa + (size_t)tk * 8);
        const float4* pp = (const float4*)(ssp + (size_t)tk * 8);
        const float4 a0 = pa[0], a1 = pa[1], b0 = pp[0], b1 = pp[1];
        const float sa_ = ((a0.x + a0.y) + (a0.z + a0.w)) + ((a1.x + a1.y) + (a1.z + a1.w));
        const float sp_ = ((b0.x + b0.y) + (b0.z + b0.w)) + ((b1.x + b1.y) + (b1.z + b1.w));
        const float ra = rsqrtf(sa_ * (1.f / 512.f) + EPS), rpv = rsqrtf(sp_ * (1.f / 512.f) + EPS);
        ((float*)(sm + L_RATIO))[tid1] = ra / rpv;
        ((float*)(sm + L_RP))[tid1] = rpv;
      } else {
        const int f = brow + tid1 - 256;
        const float gt = mod[(size_t)(l * 5 + bidx) * 3072 + 2048 + f];
        float gn = 0.f;
        if (l < 3) gn = p.norm_w[(size_t)(l + 1) * 1024 + f] * (1.f + mod[(size_t)((l + 1) * 5 + bidx) * 3072 + 1024 + f]);
        ((float2*)(sm + L_GG))[tid1 - 256] = make_float2(gt, gn);
      }
    }
    gemm256(WtOut + (size_t)brow * 1024, am + (size_t)bcol * 1024, acc, sm, [&](f32x4(&ac)[2][2][4][2]) {
      const int tidm = TIDX;
      const float* rt = (const float*)(sm + L_RATIO) + ((tidm >> 6) & 3) * 32 + (tidm & 15);
#pragma unroll
      for (int b = 0; b < 2; ++b)
#pragma unroll
        for (int n = 0; n < 2; ++n) {
          const float rv = rt[b * 128 + n * 16];
#pragma unroll
          for (int a = 0; a < 2; ++a)
#pragma unroll
            for (int m = 0; m < 4; ++m) ac[a][b][m][n] *= rv;
          __builtin_amdgcn_sched_barrier(0);
        }
    }, wave_s);
    const int tid2 = TIDX, wid2 = tid2 >> 6, lane2 = tid2 & 63;
    const int wr = wid2 >> 2, wc = wid2 & 3, fr = lane2 & 15, fq = lane2 >> 4;
    const int tk0 = bcol + wc * 32 + fr;
    const float* xsrc0 = (l == 0) ? (tk0 < NCTX ? p.x_prompt + (size_t)tk0 * 1024 : p.x_sample + (size_t)(tk0 - NCTX) * 1024)
                                  : xprev + (size_t)tk0 * 1024;
    const float* rpt = (const float*)(sm + L_RP) + wc * 32 + fr;
    const float rp[2][2] = {{rpt[0], rpt[16]}, {rpt[128], rpt[144]}};
    const float4* ggt = (const float4*)(sm + L_GG);
    float ssq[2][2] = {{0.f, 0.f}, {0.f, 0.f}};
#pragma unroll
    for (int ai = 0; ai < 2; ++ai) {
      float4 xv[4][2][2];
#pragma unroll
      for (int m = 0; m < 4; ++m)
#pragma unroll
        for (int bj = 0; bj < 2; ++bj)
#pragma unroll
          for (int n = 0; n < 2; ++n)
            xv[m][bj][n] = *(const float4*)(xsrc0 + (size_t)(bj * 128 + n * 16) * 1024 + brow + ai * 128 + wr * 64 + m * 16 + fq * 4);
#pragma unroll
      for (int m = 0; m < 4; ++m) {
        const int floc = ai * 128 + wr * 64 + m * 16 + fq * 4;
        const int f = brow + floc;
        const float4 g01 = ggt[(floc >> 1)], g23 = ggt[(floc >> 1) + 1];
#pragma unroll
        for (int bj = 0; bj < 2; ++bj)
#pragma unroll
          for (int n = 0; n < 2; ++n) {
            const int toff = bj * 128 + n * 16;
            const float rpv = rp[bj][n];
            const float4 x4 = xv[m][bj][n];
            float4 xn;
            xn.x = x4.x + g01.x * (acc[ai][bj][m][n][0] * rpv);
            xn.y = x4.y + g01.z * (acc[ai][bj][m][n][1] * rpv);
            xn.z = x4.z + g23.x * (acc[ai][bj][m][n][2] * rpv);
            xn.w = x4.w + g23.z * (acc[ai][bj][m][n][3] * rpv);
            ssq[bj][n] += (xn.x * xn.x + xn.y * xn.y) + (xn.z * xn.z + xn.w * xn.w);
            *(float4*)(xws + (size_t)(tk0 + toff) * 1024 + f) = xn;
            if (l < 3) {
              uint2 o;
              o.x = pack2(xn.x * g01.y, xn.y * g01.w);
              o.y = pack2(xn.z * g23.y, xn.w * g23.w);
              *(uint2*)(xg + (size_t)(tk0 + toff) * 1024 + f) = o;
            }
          }
      }
      __builtin_amdgcn_sched_barrier(0);
    }
#pragma unroll
    for (int bj = 0; bj < 2; ++bj)
#pragma unroll
      for (int n = 0; n < 2; ++n) {
        float s = ssq[bj][n];
        s += __shfl_xor(s, 16);
        s += __shfl_xor(s, 32);
        if (fq == 0) rowss[(size_t)(tk0 + bj * 128 + n * 16) * 8 + pm * 2 + wr] = s;
      }
  }
}

constexpr int AT_KS_BYTES = 320 * 144;
constexpr int AT_VT_STRIDE = 648;
DI void attn_tiles(const unsigned char* Ks, const unsigned char* Vt, int ntile, bool masked, int kbase, int qpos,
                   const bf16x8 (&qf)[4], float& m_run, float& l_run, f32x16 (&o)[2], int r, int h) {
  const int qa = qpos - r;
#pragma unroll 1
  for (int t = 0; t < ntile; ++t) {
    f32x16 s[2];
#pragma unroll
    for (int kt = 0; kt < 2; ++kt) {
#pragma unroll
      for (int i = 0; i < 16; ++i) s[kt][i] = 0.f;
      const unsigned char* kb = Ks + (t * 64 + kt * 32 + r) * 144 + h * 16;
#pragma unroll
      for (int ks = 0; ks < 4; ++ks) {
        const bf16x8 a = *(const bf16x8*)(kb + ks * 32);
        s[kt] = MFMA32(a, qf[ks], s[kt]);
      }
    }
    float mx = -3.0e38f;
    const int kb = kbase + t * 64;
    if (masked && (kb < qa - 97 || kb > qa + 65)) {
#pragma unroll
      for (int kt = 0; kt < 2; ++kt)
#pragma unroll
        for (int i = 0; i < 16; ++i) {
          const int d = qpos - (kb + kt * 32 + crow(i, h));
          float tv = s[kt][i];
          tv = (d > 128 || d < -128) ? -1.0e30f : tv;
          s[kt][i] = tv;
          mx = fmaxf(mx, tv);
        }
    } else {
#pragma unroll
      for (int kt = 0; kt < 2; ++kt)
#pragma unroll
        for (int i = 0; i < 16; ++i) mx = fmaxf(mx, s[kt][i]);
    }
    mx = fmaxf(mx, __shfl_xor(mx, 32));
    const float m_new = fmaxf(m_run, mx);
    const float alpha = __builtin_amdgcn_exp2f(m_run - m_new);
    m_run = m_new;
    f2_t ps2 = {0.f, 0.f};
    const f2_t mm2 = {m_new, m_new};
#pragma unroll
    for (int kt = 0; kt < 2; ++kt)
#pragma unroll
      for (int i = 0; i < 16; i += 2) {
        f2_t v2 = {s[kt][i], s[kt][i + 1]};
        v2 = v2 - mm2;
        f2_t e2 = {__builtin_amdgcn_exp2f(v2.x), __builtin_amdgcn_exp2f(v2.y)};
        s[kt][i] = e2.x;
        s[kt][i + 1] = e2.y;
        ps2 = ps2 + e2;
      }
    const float psum = ps2.x + ps2.y;
    l_run = l_run * alpha + psum;
#pragma unroll
    for (int i = 0; i < 16; ++i) { o[0][i] *= alpha; o[1][i] *= alpha; }
    bf16x8 pf[4];
#pragma unroll
    for (int st = 0; st < 4; ++st) {
      const int kt = st >> 1, s8 = (st & 1) * 8;
      uint4 u;
      u.x = pack2(s[kt][s8 + 0], s[kt][s8 + 1]);
      u.y = pack2(s[kt][s8 + 2], s[kt][s8 + 3]);
      u.z = pack2(s[kt][s8 + 4], s[kt][s8 + 5]);
      u.w = pack2(s[kt][s8 + 6], s[kt][s8 + 7]);
      pf[st] = __builtin_bit_cast(bf16x8, u);
    }
    const unsigned char* vb = Vt + r * AT_VT_STRIDE + (t * 64) * 2 + h * 8;
#pragma unroll
    for (int dt = 0; dt < 2; ++dt)
#pragma unroll
      for (int st = 0; st < 4; ++st) {
        const s16x4 lo = *(const s16x4*)(vb + dt * 32 * AT_VT_STRIDE + st * 32);
        const s16x4 hi = *(const s16x4*)(vb + dt * 32 * AT_VT_STRIDE + st * 32 + 16);
        const bf16x8 a = __builtin_shufflevector(lo, hi, 0, 1, 2, 3, 4, 5, 6, 7);
        o[dt] = MFMA32(a, pf[st], o[dt]);
      }
  }
}

DI void vt_store(unsigned char* Vt, int key, int ch, const uint4& vr) {
  ushort_t* vt = (ushort_t*)(Vt + (ch * 8) * AT_VT_STRIDE) + key;
  constexpr int S = AT_VT_STRIDE / 2;
  vt[0 * S] = (ushort_t)(vr.x & 0xffff);
  vt[1 * S] = (ushort_t)(vr.x >> 16);
  vt[2 * S] = (ushort_t)(vr.y & 0xffff);
  vt[3 * S] = (ushort_t)(vr.y >> 16);
  vt[4 * S] = (ushort_t)(vr.z & 0xffff);
  vt[5 * S] = (ushort_t)(vr.z >> 16);
  vt[6 * S] = (ushort_t)(vr.w & 0xffff);
  vt[7 * S] = (ushort_t)(vr.w >> 16);
}

DI void attn_item(const Params& p, int l, int item, unsigned char* sm, const int wave_s) {
  const ushort_t* P = (const ushort_t*)(p.ws + opq_o(OFF_P));
  ushort_t* am = (ushort_t*)(p.ws + opq_o(OFF_AM));
  float* ssa = (float*)(p.ws + opq_o(OFF_SSA));
  const int tid = TIDX, wave = tid >> 6, lane = tid & 63, r = lane & 31, h = lane >> 5;
  int b, kvh, q0, tokbase, klo, nkb;
  bool lat;
  if (item < 256) {
    lat = true;
    b = item >> 6;
    kvh = (item >> 5) & 1;
    q0 = (item & 31) * 64;
    tokbase = NCTX + b * 2048;
    klo = q0 - 128 < 0 ? 0 : q0 - 128;
    const int khi = q0 + 192 > 2048 ? 2048 : q0 + 192;
    nkb = khi - klo;
  } else {
    const int it = item - 256;
    lat = false;
    b = it >> 3;
    kvh = (it >> 2) & 1;
    q0 = (it & 3) * 64;
    tokbase = b * 256;
    klo = 0;
    nkb = 256;
  }
  const int hq = kvh * 4 + (wave & 3);
  const int qloc = q0 + (wave >> 2) * 32 + r;
  unsigned char* Ks = sm;
  unsigned char* Vt = sm + AT_KS_BYTES;
  {
    const int nch = nkb * 8;
    uint4 kr[5], vr[5];
#pragma unroll
    for (int i = 0; i < 5; ++i) {
      const int c = tid + i * 512;
      const int cc = c < nch ? c : nch - 1;
      const size_t tok = (size_t)(tokbase + klo + (cc >> 3));
      kr[i] = *(const uint4*)(P + tok * INW + 512 + kvh * 64 + (cc & 7) * 8);
      vr[i] = *(const uint4*)(P + tok * INW + 640 + kvh * 64 + (cc & 7) * 8);
    }
#pragma unroll
    for (int i = 0; i < 5; ++i) {
      const int c = tid + i * 512;
      if (c < nch) {
        *(uint4*)(Ks + (c >> 3) * 144 + (c & 7) * 16) = kr[i];
        vt_store(Vt, c >> 3, c & 7, vr[i]);
      }
    }
  }
  bf16x8 qf[4];
  {
    const ushort_t* qp = P + (size_t)(tokbase + qloc) * INW + hq * 64 + h * 8;
#pragma unroll
    for (int ks = 0; ks < 4; ++ks) qf[ks] = *(const bf16x8*)(qp + ks * 16);
  }
  uint2 gav[2][4];
  float4 anw[2][4];
  {
    const ushort_t* gp_ = P + (size_t)(tokbase + qloc) * INW + 768 + hq * 64 + 4 * h;
#pragma unroll
    for (int dt = 0; dt < 2; ++dt)
#pragma unroll
      for (int g = 0; g < 4; ++g) {
        gav[dt][g] = *(const uint2*)(gp_ + dt * 32 + 8 * g);
        anw[dt][g] = *(const float4*)(p.attn_norm + l * 512 + hq * 64 + dt * 32 + 8 * g + 4 * h);
      }
  }
  float m_run = p.sink[l * 8 + hq] * LOG2E;
  float l_run = (h == 0) ? 1.f : 0.f;
  f32x16 o[2];
#pragma unroll
  for (int i = 0; i < 16; ++i) { o[0][i] = 0.f; o[1][i] = 0.f; }
  uint4 ck[4], cv[4];
#pragma unroll
  for (int i = 0; i < 4; ++i) { ck[i] = make_uint4(0, 0, 0, 0); cv[i] = make_uint4(0, 0, 0, 0); }
  if (lat) {
    const size_t base = (size_t)((b * 4 + l) * 256);
#pragma unroll
    for (int i = 0; i < 4; ++i) {
      const int c = tid + i * 512;
      const int key = c >> 3, ch = c & 7;
      const float4* kp = (const float4*)(p.cache_k + (base + key) * 128 + kvh * 64 + ch * 8);
      const float4* vp = (const float4*)(p.cache_v + (base + key) * 128 + kvh * 64 + ch * 8);
      const float4 k0 = kp[0], k1 = kp[1], v0 = vp[0], v1 = vp[1];
      ck[i] = make_uint4(pack2(k0.x, k0.y), pack2(k0.z, k0.w), pack2(k1.x, k1.y), pack2(k1.z, k1.w));
      cv[i] = make_uint4(pack2(v0.x, v0.y), pack2(v0.z, v0.w), pack2(v1.x, v1.y), pack2(v1.z, v1.w));
    }
  }
  __syncthreads();
  attn_tiles(Ks, Vt, nkb >> 6, lat, klo, qloc, qf, m_run, l_run, o, r, h);
  if (lat) {
    __syncthreads();
#pragma unroll
    for (int i = 0; i < 4; ++i) {
      const int c = tid + i * 512;
      const int key = c >> 3, ch = c & 7;
      *(uint4*)(Ks + key * 144 + ch * 16) = ck[i];
      vt_store(Vt, key, ch, cv[i]);
    }
    __syncthreads();
    attn_tiles(Ks, Vt, 4, false, 0, qloc, qf, m_run, l_run, o, r, h);
  }
  const float l_tot = l_run + __shfl_xor(l_run, 32);
  const float inv = __builtin_amdgcn_rcpf(l_tot);
  const size_t m = (size_t)(tokbase + qloc);
  const float* an = p.attn_norm + l * 512 + hq * 64;
  float ssq = 0.f;
#pragma unroll
  for (int dt = 0; dt < 2; ++dt)
#pragma unroll
    for (int g = 0; g < 4; ++g) {
      const int d = dt * 32 + 8 * g + 4 * h;
      const uint2 gavv = gav[dt][g];
      const float4 w4 = anw[dt][g];
      const float o0 = o[dt][4 * g + 0] * inv, o1 = o[dt][4 * g + 1] * inv, o2 = o[dt][4 * g + 2] * inv,
                  o3 = o[dt][4 * g + 3] * inv;
      ssq += (o0 * o0 + o1 * o1) + (o2 * o2 + o3 * o3);
      uint2 ov;
      ov.x = pack2(o0 * w4.x * silu_f(bflo(gavv.x)), o1 * w4.y * silu_f(bfhi(gavv.x)));
      ov.y = pack2(o2 * w4.z * silu_f(bflo(gavv.y)), o3 * w4.w * silu_f(bfhi(gavv.y)));
      *(uint2*)(am + m * 1024 + hq * 64 + d) = ov;
    }
  ssq += __shfl_xor(ssq, 32);
  if (h == 0) ssa[m * 8 + hq] = ssq;
}

template <int HALF>
DI void pool_window(const unsigned char* U, unsigned char* Pm, int t0, int L, int tid) {
  const int cp = tid & 63, seg = tid >> 6;
  const int tl0 = seg * 16;
  const unsigned char* up = U + (tl0 + 8 - HALF) * 272 + cp * 4;
  float s0 = 0.f, s1 = 0.f;
#pragma unroll
  for (int j = 0; j < 2 * HALF; ++j) {
    const unsigned u = *(const unsigned*)(up + j * 272);
    s0 += bflo(u);
    s1 += bfhi(u);
  }
#pragma unroll
  for (int i = 0; i < 16; ++i) {
    const int tl = tl0 + i;
    const int t = t0 + tl;
    const int lo = t - HALF < 0 ? 0 : t - HALF;
    const int hi = t + HALF > L ? L : t + HALF;
    const unsigned xc = *(const unsigned*)(U + (tl + 8) * 272 + cp * 4);
    const float invc = __builtin_amdgcn_rcpf((float)(hi - lo));
    *(unsigned*)(Pm + tl * 272 + cp * 4) = pack2(s0 * invc - bflo(xc), s1 * invc - bfhi(xc));
    if (i < 15) {
      const unsigned ua = *(const unsigned*)(up + (i + 2 * HALF) * 272);
      const unsigned ub = *(const unsigned*)(up + i * 272);
      s0 += bflo(ua) - bflo(ub);
      s1 += bfhi(ua) - bfhi(ub);
    }
  }
}

DI void pool_item(const Params& p, int l, int item, unsigned char* sm, const int wave_s) {
  const ushort_t* P = (const ushort_t*)(p.ws + opq_o(OFF_P));
  ushort_t* am = (ushort_t*)(p.ws + opq_o(OFF_AM));
  float* ssp = (float*)(p.ws + opq_o(OFF_SSP));
  const ushort_t* Wp = (const ushort_t*)(p.ws + opq_o(OFF_WTPOOL));
  const int tid = TIDX, wave = tid >> 6, lane = tid & 63, r = lane & 31, h = lane >> 5;
  const int tt = item >> 2, g = item & 3;
  const int m0 = tt * 128;
  int L, sbase;
  if (m0 < NCTX) { L = 256; sbase = m0 & ~255; } else { L = 2048; sbase = NCTX + ((m0 - NCTX) & ~2047); }
  const int t0 = m0 - sbase;
  unsigned char* U = sm;
  unsigned char* W = sm + 39168;
  unsigned char* Pm = sm + 39168 + 34816;
  const ushort_t* wsrc = Wp + (size_t)(l * 4 + g) * 128 * 128;
  {
    uint4 uu[5], ww[4];
#pragma unroll
    for (int i = 0; i < 5; ++i) {
      const int c = tid + i * 512;
      const int row = c >> 4, ch = c & 15;
      const int pos = t0 - 8 + row;
      uu[i] = make_uint4(0, 0, 0, 0);
      if (c < 144 * 16 && pos >= 0 && pos < L) uu[i] = *(const uint4*)(P + (size_t)(sbase + pos) * INW + 1280 + g * 128 + ch * 8);
    }
#pragma unroll
    for (int i = 0; i < 4; ++i) {
      const int c = tid + i * 512;
      ww[i] = *(const uint4*)(wsrc + (c >> 4) * 128 + (c & 15) * 8);
    }
#pragma unroll
    for (int i = 0; i < 5; ++i) {
      const int c = tid + i * 512;
      if (c < 144 * 16) *(uint4*)(U + (c >> 4) * 272 + (c & 15) * 16) = uu[i];
    }
#pragma unroll
    for (int i = 0; i < 4; ++i) {
      const int c = tid + i * 512;
      *(uint4*)(W + (c >> 4) * 272 + (c & 15) * 16) = ww[i];
    }
  }
  const int wm = wave & 3, wn = wave >> 2;
  const size_t m = (size_t)(m0 + wm * 32 + r);
  uint2 gpv_[2][4];
  float4 ps_[2][4], pn_[2][4];
#pragma unroll
  for (int nt = 0; nt < 2; ++nt)
#pragma unroll
    for (int gq = 0; gq < 4; ++gq)
    {
      const int c_ = g * 128 + wn * 64 + nt * 32 + 8 * gq + 4 * h;
      gpv_[nt][gq] = *(const uint2*)(P + m * INW + 1792 + c_);
      ps_[nt][gq] = *(const float4*)(p.pool_scale + l * 512 + c_);
      pn_[nt][gq] = *(const float4*)(p.pool_norm + l * 512 + c_);
    }
  __syncthreads();
  switch (g) {
    case 0: pool_window<1>(U, Pm, t0, L, tid); break;
    case 1: pool_window<2>(U, Pm, t0, L, tid); break;
    case 2: pool_window<4>(U, Pm, t0, L, tid); break;
    default: pool_window<8>(U, Pm, t0, L, tid); break;
  }
  __syncthreads();
  f32x16 acc[2];
#pragma unroll
  for (int i = 0; i < 16; ++i) { acc[0][i] = 0.f; acc[1][i] = 0.f; }
  const unsigned char* wa = W + (wn * 64 + r) * 272 + h * 16;
  const unsigned char* pb = Pm + (wm * 32 + r) * 272 + h * 16;
#pragma unroll
  for (int ks = 0; ks < 8; ++ks) {
    const bf16x8 bq = *(const bf16x8*)(pb + ks * 32);
    const bf16x8 a0 = *(const bf16x8*)(wa + ks * 32);
    const bf16x8 a1 = *(const bf16x8*)(wa + 32 * 272 + ks * 32);
    acc[0] = MFMA32(a0, bq, acc[0]);
    acc[1] = MFMA32(a1, bq, acc[1]);
  }
  float ssq = 0.f;
#pragma unroll
  for (int nt = 0; nt < 2; ++nt)
#pragma unroll
    for (int gq = 0; gq < 4; ++gq) {
      const int c = g * 128 + wn * 64 + nt * 32 + 8 * gq + 4 * h;
      const float4 ps = ps_[nt][gq];
      const float4 pn = pn_[nt][gq];
      const uint2 gpv = gpv_[nt][gq];
      const float o0 = acc[nt][4 * gq + 0] * ps.x, o1 = acc[nt][4 * gq + 1] * ps.y, o2 = acc[nt][4 * gq + 2] * ps.z,
                  o3 = acc[nt][4 * gq + 3] * ps.w;
      ssq += (o0 * o0 + o1 * o1) + (o2 * o2 + o3 * o3);
      uint2 ov;
      ov.x = pack2(o0 * pn.x * silu_f(bflo(gpv.x)), o1 * pn.y * silu_f(bfhi(gpv.x)));
      ov.y = pack2(o2 * pn.z * silu_f(bflo(gpv.y)), o3 * pn.w * silu_f(bfhi(gpv.y)));
      *(uint2*)(am + m * 1024 + 512 + c) = ov;
    }
  ssq += __shfl_xor(ssq, 32);
  if (h == 0) ssp[m * 8 + g * 2 + wn] = ssq;
}

DI void transpose_item(const float* __restrict__ src, ushort_t* __restrict__ dst, int R, int C, int r0, int c0,
                       unsigned char* sm, int t256) {
  float* T = (float*)sm;
  const int rr = t256 >> 4, cc4 = (t256 & 15) * 4;
#pragma unroll
  for (int i = 0; i < 4; ++i) {
    const int row = rr + 16 * i;
    const float4 v = *(const float4*)(src + (size_t)(r0 + row) * C + c0 + cc4);
    T[row * 65 + cc4 + 0] = v.x;
    T[row * 65 + cc4 + 1] = v.y;
    T[row * 65 + cc4 + 2] = v.z;
    T[row * 65 + cc4 + 3] = v.w;
  }
  __syncthreads();
  const int c = t256 >> 2, rseg = (t256 & 3) * 16;
  uint4 o0, o1;
  o0.x = pack2(T[(rseg + 0) * 65 + c], T[(rseg + 1) * 65 + c]);
  o0.y = pack2(T[(rseg + 2) * 65 + c], T[(rseg + 3) * 65 + c]);
  o0.z = pack2(T[(rseg + 4) * 65 + c], T[(rseg + 5) * 65 + c]);
  o0.w = pack2(T[(rseg + 6) * 65 + c], T[(rseg + 7) * 65 + c]);
  o1.x = pack2(T[(rseg + 8) * 65 + c], T[(rseg + 9) * 65 + c]);
  o1.y = pack2(T[(rseg + 10) * 65 + c], T[(rseg + 11) * 65 + c]);
  o1.z = pack2(T[(rseg + 12) * 65 + c], T[(rseg + 13) * 65 + c]);
  o1.w = pack2(T[(rseg + 14) * 65 + c], T[(rseg + 15) * 65 + c]);
  ushort_t* d = dst + (size_t)(c0 + c) * R + r0 + rseg;
  *(uint4*)d = o0;
  *(uint4*)(d + 8) = o1;
}


template <bool NT>
DI void transpose_strip(const float* __restrict__ src, ushort_t* __restrict__ dst, int R, int C, int r0, int c0,
                        unsigned char* sm, int t256) {
  float* T = (float*)sm;
  const int rr = t256 >> 6, cc4 = (t256 & 63) * 4;
  float4 v[16];
#pragma unroll
  for (int i = 0; i < 16; ++i) {
    const float* q = src + (size_t)(r0 + rr + 4 * i) * C + c0 + cc4;
    if constexpr (NT) {
      const f32x4 t4 = __builtin_nontemporal_load((const f32x4*)q);
      v[i] = make_float4(t4[0], t4[1], t4[2], t4[3]);
    } else {
      v[i] = *(const float4*)q;
    }
  }
#pragma unroll
  for (int i = 0; i < 16; ++i) {
    float* t = T + (rr + 4 * i) * 257 + cc4;
    t[0] = v[i].x; t[1] = v[i].y; t[2] = v[i].z; t[3] = v[i].w;
  }
  __syncthreads();
  ushort_t* d = dst + (size_t)(c0 + t256) * R + r0;
#pragma unroll
  for (int g = 0; g < 8; ++g) {
    uint4 o;
    o.x = pack2(T[(8 * g + 0) * 257 + t256], T[(8 * g + 1) * 257 + t256]);
    o.y = pack2(T[(8 * g + 2) * 257 + t256], T[(8 * g + 3) * 257 + t256]);
    o.z = pack2(T[(8 * g + 4) * 257 + t256], T[(8 * g + 5) * 257 + t256]);
    o.w = pack2(T[(8 * g + 6) * 257 + t256], T[(8 * g + 7) * 257 + t256]);
    *(uint4*)(d + 8 * g) = o;
  }
}

DI void weight_pair_item(const Params& p, int L, int it, unsigned char* sm, const int wave_s) {
  const int tid = TIDX;
  const int half = tid >> 8, t256 = tid & 255;
  if (it < 72) {
    const int it2 = it * 2 + half;
    const int rt = it2 / 9, ct = it2 % 9;
    transpose_strip<false>(p.w_in + (size_t)L * 1024 * 2304, (ushort_t*)(p.ws + OFF_WTIN) + (size_t)L * 2304 * 1024, 1024, 2304,
                    rt * 64, ct * 256, sm + half * 65792, t256);
  } else if (it < 72 + 32) {
    const int it2 = (it - 72) * 2 + half;
    const int rt = it2 >> 2, ct = it2 & 3;
    transpose_strip<true>(p.w_out + (size_t)L * 1024 * 1024, (ushort_t*)(p.ws + OFF_WTOUT) + (size_t)L * 1024 * 1024, 1024, 1024,
                    rt * 64, ct * 256, sm + half * 65792, t256);
  } else {
    const int it2 = (it - 72 - 32) * 2 + half;
    const int mat = L * 4 + (it2 >> 2), rt = (it2 >> 1) & 1, ct = it2 & 1;
    transpose_item(p.w_pool + (size_t)mat * 128 * 128, (ushort_t*)(p.ws + OFF_WTPOOL) + (size_t)mat * 128 * 128, 128, 128,
                   rt * 64, ct * 64, sm + half * 16640, t256);
  }
}

DI void mod_item(const Params& p, int L, int cg64, unsigned char* sm, const int wave_s) {
  const int tid = TIDX, wave = tid >> 6, lane = tid & 63;
  float* sv = (float*)sm;
  float* red = (float*)(sm + 20480);
  for (int idx = tid; idx < 5120; idx += 512) {
    const int rr = idx >> 10, k = idx & 1023;
    const float cv = rr == 0 ? p.c_ctx[k] : p.c[(rr - 1) * 1024 + k];
    sv[idx] = silu_f(cv);
  }
  __syncthreads();
  const int j = cg64 * 64 + lane;
  const float* wp = p.w_ada + ((size_t)L * 1024 + wave * 128) * 3072 + j;
  const float* s0 = sv + wave * 128;
  float a0 = 0.f, a1 = 0.f, a2 = 0.f, a3 = 0.f, a4 = 0.f;
#pragma unroll 8
  for (int kk = 0; kk < 128; ++kk) {
    const float w = __builtin_nontemporal_load(wp + (size_t)kk * 3072);
    a0 += s0[kk] * w;
    a1 += s0[1024 + kk] * w;
    a2 += s0[2048 + kk] * w;
    a3 += s0[3072 + kk] * w;
    a4 += s0[4096 + kk] * w;
  }
  float* rd = red + (wave * 5) * 64 + lane;
  rd[0] = a0; rd[64] = a1; rd[128] = a2; rd[192] = a3; rd[256] = a4;
  __syncthreads();
  if (tid < 320) {
    const int rr = tid >> 6, c = tid & 63;
    float s = p.b_ada[L * 3072 + cg64 * 64 + c];
#pragma unroll
    for (int w = 0; w < 8; ++w) s += red[(w * 5 + rr) * 64 + c];
    ((float*)(p.ws + OFF_MOD))[(size_t)(L * 5 + rr) * 3072 + cg64 * 64 + c] = s;
  }
}

DI void sw_item(const Params& p, int L, int it, unsigned char* sm, const int wave_s) {
  const int tid = TIDX, half = tid >> 8, t256 = tid & 255;
  const int kc = it / 5, cgp = (it % 5) * 2 + half;
  const float* mod = (const float*)(p.ws + OFF_MOD);
  float* sh = (float*)sm + half * 320;
  for (int idx = t256; idx < 320; idx += 256) {
    const int rr = idx >> 6, kk = idx & 63;
    sh[idx] = mod[(size_t)(L * 5 + rr) * 3072 + kc * 64 + kk];
  }
  __syncthreads();
  if (cgp < 9) {
    const int n = cgp * 256 + t256;
    float a0 = 0.f, a1 = 0.f, a2 = 0.f, a3 = 0.f, a4 = 0.f;
    const float* wp = p.w_in + ((size_t)L * 1024 + kc * 64) * 2304 + n;
#pragma unroll 8
    for (int kk = 0; kk < 64; ++kk) {
      const float w = __builtin_nontemporal_load(wp + (size_t)kk * 2304);
      a0 += sh[kk] * w;
      a1 += sh[64 + kk] * w;
      a2 += sh[128 + kk] * w;
      a3 += sh[192 + kk] * w;
      a4 += sh[256 + kk] * w;
    }
    float* sp = (float*)(p.ws + OFF_SWPART) + ((size_t)(kc * 4 + L) * 5) * 2304 + n;
    sp[0] = a0; sp[2304] = a1; sp[2 * 2304] = a2; sp[3 * 2304] = a3; sp[4 * 2304] = a4;
  }
}

DI void sincos_d(double a, double& sn, double& cs) {
  const double twopi = 6.283185307179586476925;
  const double n = rint(a / twopi);
  const double x = a - n * twopi;
  const double x2 = x * x;
  double ts = x, tc = 1.0, s = x, c = 1.0;
#pragma unroll 1
  for (int k = 1; k <= 16; ++k) {
    tc = -tc * x2 / (double)((2 * k - 1) * (2 * k));
    ts = -ts * x2 / (double)((2 * k) * (2 * k + 1));
    c += tc;
    s += ts;
  }
  sn = s;
  cs = c;
}

__global__ void __launch_bounds__(512, 2) fwd_megakernel(Params p) {
  cg::grid_group grid = cg::this_grid();
  __shared__ __attribute__((aligned(16))) unsigned char sm[SMEM_TOTAL];
  uint4& xb_words = *(uint4*)(sm + L_XB);
  const int nblk = gridDim.x;
  const int wave_s = __builtin_amdgcn_readfirstlane((int)(threadIdx.x >> 6));
  if (p.ws == nullptr) grid.sync();
  const bool is_t0 = (TIDX == 0);
  if (is_t0) xb_words = make_uint4(0u, 0u, 0u, 0u);
  __syncthreads();
  (void)xcd_barrier_post((unsigned*)(p.ws + OFF_BAR), (volatile LAS unsigned*)&xb_words, is_t0);
#define GRID_SYNC()                                            \
  do {                                                         \
    XcdBarrier xb_;                                            \
    xb_.bar = (unsigned*)(p.ws + opq_o(OFF_BAR));              \
    xb_.x = xb_xcc_id();                                       \
    xb_.st = (volatile LAS unsigned*)&xb_words;                \
    xcd_barrier(xb_, TIDX == 0);                               \
  } while (0)

  {
    const int tid = TIDX;
    constexpr int TOTAL = 4 * N_TPAIR + 4 * 48 + 1;
    for (int item = blockIdx.x; item < TOTAL; item += nblk) {
      __syncthreads();
      if (item < 4 * N_TPAIR) {
        weight_pair_item(p, item / N_TPAIR, item % N_TPAIR, sm, wave_s);
      } else if (item < 4 * N_TPAIR + 192) {
        mod_item(p, (item - 4 * N_TPAIR) / 48, (item - 4 * N_TPAIR) % 48, sm, wave_s);
      } else {
        float2* rc = (float2*)(p.ws + OFF_ROPE);
        for (int idx = tid; idx < 1024; idx += 512) {
          const int pos = idx >> 4, fi = idx & 15;
          const float inv = __builtin_amdgcn_exp2f(-(float)fi * (1.f / 16.f) * 13.287712379549449f);
          const float ang = (float)pos * inv;
          double sn, cs;
          sincos_d((double)ang, sn, cs);
          rc[idx] = make_float2((float)cs, (float)sn);
        }
      }
    }
  }
  GRID_SYNC();
  {
    for (int item = blockIdx.x; item < 4 * N_SWITEM; item += nblk) {
      __syncthreads();
      sw_item(p, item / N_SWITEM, item % N_SWITEM, sm, wave_s);
    }
    const float* mod = (const float*)(p.ws + OFF_MOD);
    ushort_t* xg = (ushort_t*)(p.ws + OFF_XG);
    float* rowss = (float*)(p.ws + OFF_ROWSS);
    const int tidr = TIDX, lane = tidr & 63;
    const int rstride = nblk * 8;
    for (int row0 = blockIdx.x * 8 + (tidr >> 6); row0 < NTOK; row0 += 6 * rstride) {
      float4 v[6][4];
      bool ok[6];
#pragma unroll
      for (int u = 0; u < 6; ++u) {
        const int row = row0 + u * rstride;
        ok[u] = row < NTOK;
        const int rw = ok[u] ? row : row0;
        const float* src = rw < NCTX ? p.x_prompt + (size_t)rw * 1024 : p.x_sample + (size_t)(rw - NCTX) * 1024;
#pragma unroll
        for (int i = 0; i < 4; ++i) v[u][i] = *(const float4*)(src + lane * 4 + 256 * i);
      }
#pragma unroll
      for (int u = 0; u < 6; ++u) {
        const int row = row0 + u * rstride;
        if (!ok[u]) continue;
        const float* scl = mod + (size_t)mod_row(row) * 3072 + 1024;
        float ss = 0.f;
#pragma unroll
        for (int i = 0; i < 4; ++i) {
          const int n = lane * 4 + 256 * i;
          const float4 x4 = v[u][i];
          const float4 sc = *(const float4*)(scl + n);
          const float4 w4 = *(const float4*)(p.norm_w + n);
          ss += (x4.x * x4.x + x4.y * x4.y) + (x4.z * x4.z + x4.w * x4.w);
          uint2 o;
          o.x = pack2(x4.x * (w4.x * (1.f + sc.x)), x4.y * (w4.y * (1.f + sc.y)));
          o.y = pack2(x4.z * (w4.z * (1.f + sc.z)), x4.w * (w4.w * (1.f + sc.w)));
          *(uint2*)(xg + (size_t)row * 1024 + n) = o;
        }
#pragma unroll
        for (int off = 32; off >= 1; off >>= 1) ss += __shfl_xor(ss, off);
        if (lane < 8) rowss[(size_t)row * 8 + lane] = lane == 0 ? ss : 0.f;
      }
    }
  }
  GRID_SYNC();
#pragma unroll 1
  for (int l = 0; l < 4; ++l) {
    phase_inproj(p, l, sm, wave_s);
    GRID_SYNC();
    if (nblk == 256) {
      const int xq = blockIdx.x & 7, rq = blockIdx.x >> 3;
      __syncthreads();
      attn_item(p, l, (rq >> 3) * 64 + ((rq >> 2) & 1) * 32 + 4 * xq + (rq & 3), sm, wave_s);
      __syncthreads();
      if (rq < 16) {
        attn_item(p, l, 256 + (xq + 8 * (rq >> 3)) * 8 + ((rq >> 2) & 1) * 4 + (rq & 3), sm, wave_s);
      } else {
        const int e = rq - 16;
        pool_item(p, l, (2 * (xq + 8 * (e >> 3)) + ((e >> 2) & 1)) * 4 + (e & 3), sm, wave_s);
      }
      __syncthreads();
      {
        const int e = 16 + rq;
        pool_item(p, l, (2 * (xq + 8 * (e >> 3)) + ((e >> 2) & 1)) * 4 + (e & 3), sm, wave_s);
      }
    } else {
      for (int item = blockIdx.x; item < 384 + 384; item += nblk) {
        __syncthreads();
        if (item < 384) attn_item(p, l, item, sm, wave_s);
        else pool_item(p, l, item - 384, sm, wave_s);
      }
    }
    GRID_SYNC();
    phase_outproj(p, l, sm, wave_s);
    GRID_SYNC();
  }
  {
    const float* xws = (const float*)(p.ws + OFF_X);
    const float* rowss = (const float*)(p.ws + OFF_ROWSS);
    const int tidr = TIDX, lane = tidr & 63;
    const int rstride = nblk * 8;
    for (int row0 = blockIdx.x * 8 + (tidr >> 6); row0 < NTOK; row0 += 6 * rstride) {
      float4 v[6][4];
      float rr[6];
#pragma unroll
      for (int u = 0; u < 6; ++u) {
        const int row = (row0 + u * rstride) < NTOK ? (row0 + u * rstride) : row0;
        const float4* rs = (const float4*)(rowss + (size_t)row * 8);
        const float4 s0 = rs[0], s1 = rs[1];
        rr[u] = rsqrtf((((s0.x + s0.y) + (s0.z + s0.w)) + ((s1.x + s1.y) + (s1.z + s1.w))) * (1.f / 1024.f) + EPS);
#pragma unroll
        for (int i = 0; i < 4; ++i) v[u][i] = *(const float4*)(xws + (size_t)row * 1024 + lane * 4 + 256 * i);
      }
#pragma unroll
      for (int u = 0; u < 6; ++u) {
        const int row = row0 + u * rstride;
        if (row >= NTOK) continue;
#pragma unroll
        for (int i = 0; i < 4; ++i) {
          const int n = lane * 4 + 256 * i;
          const float4 w4 = *(const float4*)(p.final_norm + n);
          const float4 x4 = v[u][i];
          *(float4*)(p.out + (size_t)row * 1024 + n) =
              make_float4(x4.x * rr[u] * w4.x, x4.y * rr[u] * w4.y, x4.z * rr[u] * w4.z, x4.w * rr[u] * w4.w);
        }
      }
    }
  }
}

extern "C" void kernel_launch(void* const* d_in, const int* in_sizes, int n_in, void* d_out, int out_size, void* d_ws,
                              size_t ws_size, hipStream_t stream) {
  static int grid_blocks = 0;
  if (!grid_blocks) {
    int dev = 0, cus = 0, per_cu = 0;
    (void)hipGetDevice(&dev);
    (void)hipDeviceGetAttribute(&cus, hipDeviceAttributeMultiprocessorCount, dev);
    (void)hipOccupancyMaxActiveBlocksPerMultiprocessor(&per_cu, fwd_megakernel, 512, 0);
    if (per_cu < 1) fprintf(stderr, "occupancy query reports %d blocks per CU\n", per_cu);
    grid_blocks = cus;
  }
  Params p{};
  p.x_prompt = (const float*)d_in[0];
  p.x_sample = (const float*)d_in[1];
  p.cache_k = (const float*)d_in[2];
  p.cache_v = (const float*)d_in[3];
  p.c = (const float*)d_in[4];
  p.c_ctx = (const float*)d_in[5];
  p.norm_w = (const float*)d_in[6];
  p.w_ada = (const float*)d_in[7];
  p.b_ada = (const float*)d_in[8];
  p.w_in = (const float*)d_in[9];
  p.sink = (const float*)d_in[10];
  p.attn_norm = (const float*)d_in[11];
  p.pool_norm = (const float*)d_in[12];
  p.w_pool = (const float*)d_in[13];
  p.pool_scale = (const float*)d_in[14];
  p.w_out = (const float*)d_in[15];
  p.final_norm = (const float*)d_in[16];
  p.out = (float*)d_out;
  p.ws = (unsigned char*)d_ws;
  (void)hipMemsetAsync((unsigned char*)d_ws + OFF_BAR, 0, XCD_BAR_WORDS * 4, stream);
  void* args[] = {&p};
  hipError_t e = hipLaunchCooperativeKernel((void*)fwd_megakernel, dim3(grid_blocks), dim3(512), args, 0, stream);
  if (e != hipSuccess) fprintf(stderr, "cooperative launch failed: %s (grid %d)\n", hipGetErrorString(e), grid_blocks);
}
```

```cpp
#include <hip/hip_runtime.h>
#include <hip/hip_cooperative_groups.h>
#include <cstdio>
namespace cg = cooperative_groups;

typedef __attribute__((ext_vector_type(8))) short bf16x8;
typedef __attribute__((ext_vector_type(4))) short s16x4;
typedef __attribute__((ext_vector_type(16))) float f32x16;
typedef __attribute__((ext_vector_type(4))) float f32x4;
typedef __bf16 bf2_t __attribute__((ext_vector_type(2)));
typedef float f2_t __attribute__((ext_vector_type(2)));
typedef unsigned short ushort_t;

#define DI __device__ __forceinline__
#define MFMA32(a, b, c) __builtin_amdgcn_mfma_f32_32x32x16_bf16((a), (b), (c), 0, 0, 0)

constexpr int NTOK = 12288, NCTX = 4096, DM = 1024, INW = 2304;
constexpr float EPS = 1e-6f;
constexpr float LOG2E = 1.4426950408889634f;

constexpr size_t OFF_WTIN = 0;
constexpr size_t OFF_WTOUT = OFF_WTIN + 4ull * 2304 * 1024 * 2;
constexpr size_t OFF_WTPOOL = OFF_WTOUT + 4ull * 1024 * 1024 * 2;
constexpr size_t OFF_MODPART = OFF_WTPOOL + 4ull * 4 * 128 * 128 * 2;
constexpr size_t OFF_MOD = OFF_MODPART + 16ull * 4 * 5 * 3072 * 4;
constexpr size_t OFF_SWPART = OFF_MOD + 4ull * 5 * 3072 * 4;
constexpr size_t OFF_SW = OFF_SWPART + 16ull * 4 * 5 * 2304 * 4;
constexpr size_t OFF_ROPE = OFF_SW + 4ull * 5 * 2304 * 4;
constexpr size_t OFF_X = OFF_ROPE + 64 * 16 * 8;
constexpr size_t OFF_XG = OFF_X + 12288ull * 1024 * 4;
constexpr size_t OFF_P = OFF_XG + 12288ull * 1024 * 2;
constexpr size_t OFF_AM = OFF_P + 12288ull * 2304 * 2;
constexpr size_t OFF_ROWSS = OFF_AM + 12288ull * 1024 * 2;
constexpr size_t OFF_SSA = OFF_ROWSS + 12288ull * 16 * 4;
constexpr size_t OFF_SSP = OFF_SSA + 12288ull * 8 * 4;
constexpr size_t OFF_BAR = OFF_SSP + 12288ull * 8 * 4;
constexpr size_t OFF_X1 = OFF_BAR + 16384;

constexpr int SMEM_BYTES = 131072;
constexpr int L_RATIO = SMEM_BYTES;
constexpr int L_RP = L_RATIO + 1024;
constexpr int L_GG = L_RP + 1024;
constexpr int L_SW = L_GG + 2048;
constexpr int L_RR = L_SW + 1024;
constexpr int L_ROPE = L_RR + 1024;
constexpr int L_XB = L_ROPE + 8192;
constexpr int SMEM_TOTAL = L_XB + 16;

struct Params {
  const float *x_prompt, *x_sample, *cache_k, *cache_v, *c, *c_ctx, *norm_w, *w_ada, *b_ada, *w_in, *sink, *attn_norm,
      *pool_norm, *w_pool, *pool_scale, *w_out, *final_norm;
  float* out;
  unsigned char* ws;
};

DI unsigned pack2(float a, float b) {
  f2_t v = {a, b};
  return __builtin_bit_cast(unsigned, __builtin_convertvector(v, bf2_t));
}
DI float bflo(unsigned u) { return __uint_as_float(u << 16); }
DI float bfhi(unsigned u) { return __uint_as_float(u & 0xffff0000u); }
DI float silu_f(float x) { return x * __builtin_amdgcn_rcpf(1.f + __expf(-x)); }
DI int opq(int x) { asm volatile("" : "+v"(x)); return x; }
DI int lane_id_v() {
  int r;
  asm volatile("v_mbcnt_lo_u32_b32 %0, -1, 0\n\tv_mbcnt_hi_u32_b32 %0, -1, %0" : "=v"(r));
  return r;
}
#define TIDX (wave_s * 64 + lane_id_v())
DI size_t opq_o(size_t o) { asm volatile("" : "+s"(o)); return o; }
DI int crow(int i, int h) { return (i & 3) + 8 * (i >> 2) + 4 * h; }


#define XB_TMO      128
#define XB_XCNT(j)  (256  + 64 * (j))
#define XB_XSUB(j)  (1280 + 64 * (j))
#define XB_XGEN(j)  (2304 + 64 * (j))
#define XB_TOP      3328
#define XB_TOPGEN   3392
#define XCD_BAR_WORDS 3456
#define XB_SPIN_CAP (1u << 18)
#define LAS __attribute__((address_space(3)))
DI unsigned xb_ld(unsigned* p) { return __hip_atomic_load(p, __ATOMIC_RELAXED, __HIP_MEMORY_SCOPE_AGENT); }
DI unsigned xb_add(unsigned* p, unsigned v) { return __hip_atomic_fetch_add(p, v, __ATOMIC_RELAXED, __HIP_MEMORY_SCOPE_AGENT); }
DI unsigned xb_xcc_id() { return (unsigned)__builtin_amdgcn_s_getreg((3 << 11) | 20) & 0xFu; }
#define XB_SPIN(cond, bar) do { unsigned _sp = 0; while (cond) { __builtin_amdgcn_s_sleep(1); \
    if ((++_sp & 255u) == 0u) { if (xb_ld(&(bar)[XB_TMO])) break; if (_sp > XB_SPIN_CAP) { atomicAdd(&(bar)[XB_TMO], 1u); break; } } } } while (0)
struct XcdBarrier { unsigned* bar; unsigned x; volatile LAS unsigned* st; };
DI XcdBarrier xcd_barrier_post(unsigned* bar, volatile LAS unsigned* st, bool is_t0) {
  XcdBarrier b; b.bar = bar; b.x = xb_xcc_id(); b.st = st;
  if (is_t0) (void)xb_add(&bar[XB_XCNT(b.x)], 1u);
  return b;
}
DI void xcd_barrier_complete(unsigned* bar, unsigned x, unsigned& nloc, unsigned& nx) {
  const unsigned G = gridDim.x * gridDim.y * gridDim.z;
  unsigned sum, cnt, mine, sp = 0u;
  for (;;) {
    sum = 0u; cnt = 0u; mine = 0u;
#pragma unroll
    for (unsigned j = 0; j < 16; ++j) { const unsigned c = xb_ld(&bar[XB_XCNT(j)]); sum += c; cnt += (c > 0u) ? 1u : 0u; mine = (j == x) ? c : mine; }
    if (sum == G) break;
    __builtin_amdgcn_s_sleep(1);
    if ((++sp & 255u) == 0u) { if (xb_ld(&bar[XB_TMO])) break; if (sp > XB_SPIN_CAP) { atomicAdd(&bar[XB_TMO], 1u); break; } }
  }
  nloc = mine > 0u ? mine : 1u; nx = cnt > 0u ? cnt : 1u;
}
DI void xcd_barrier(const XcdBarrier& b, bool is_t0) {
  asm volatile("s_waitcnt vmcnt(0)" ::: "memory");
  __syncthreads();
  if (is_t0) {
    unsigned* bar = b.bar;
    __builtin_amdgcn_s_waitcnt(0);
    unsigned nloc = b.st[0], nx = b.st[1];
    if (nloc == 0u) { xcd_barrier_complete(bar, b.x, nloc, nx); b.st[0] = nloc; b.st[1] = nx; }
    const unsigned old = xb_add(&bar[XB_XSUB(b.x)], 1u);
    const unsigned gen = old / nloc;
    if (old + 1u == (gen + 1u) * nloc) {
      __builtin_amdgcn_fence(__ATOMIC_RELEASE, "agent");
      asm volatile("s_waitcnt vmcnt(0)" ::: "memory");
      const unsigned og = xb_add(&bar[XB_TOP], 1u);
      const unsigned tg = og / nx;
      if (og + 1u == (tg + 1u) * nx) xb_add(&bar[XB_TOPGEN], 1u);
      else XB_SPIN(xb_ld(&bar[XB_TOPGEN]) == tg, bar);
      __builtin_amdgcn_fence(__ATOMIC_ACQUIRE, "agent");
      xb_add(&bar[XB_XGEN(b.x)], 1u);
      asm volatile("s_waitcnt vmcnt(0)" ::: "memory");
    } else {
      XB_SPIN(xb_ld(&bar[XB_XGEN(b.x)]) == gen, bar);
      __builtin_amdgcn_fence(__ATOMIC_ACQUIRE, "agent");
      asm volatile("s_waitcnt vmcnt(0)" ::: "memory");
    }
  }
  __syncthreads();
}


constexpr int G_HT = 128 * 64;
DI int lds_byte(int r, int c) {
  int st = (r >> 4) * 2 + (c >> 5), rr = r & 15, cc = c & 31, ob = rr * 64 + cc * 2;
  return st * 1024 + (ob ^ (((ob >> 9) & 1) << 5));
}
DI void stage_rc(int b, int& R, int& C) {
  int st = b / 1024, sb = b % 1024, swz = sb ^ (((sb >> 9) & 1) << 5);
  R = (st >> 1) * 16 + swz / 64;
  C = (st & 1) * 32 + (swz % 64) / 2;
}

template <class Mid>
DI void gemm256(const ushort_t* __restrict__ A, const ushort_t* __restrict__ Bt, f32x4 (&acc)[2][2][4][2],
                unsigned char* shm_, Mid mid, const int wave_s) {
  constexpr int K = 1024, BK = 64, HALF = 128, nt = K / BK;
  ushort_t* shm = (ushort_t*)shm_;
  const int tid = TIDX;
  const int wid = tid >> 6, lane = tid & 63, wr = wid >> 2, wc = wid & 3, fr = lane & 15, fq = lane >> 4;
  unsigned go0, go1;
  {
    int r_, c_;
    stage_rc(tid * 16, r_, c_);
    go0 = (unsigned)(r_ * K + c_) * 2u;
    stage_rc(tid * 16 + 8192, r_, c_);
    go1 = (unsigned)(r_ * K + c_) * 2u;
  }
#define SA(b, h) (shm + ((b) * 2 + (h)) * G_HT)
#define SB(b, h) (shm + (4 + (b) * 2 + (h)) * G_HT)
#define STAGE(P, BASE, br, kt)                                                                                      \
  do {                                                                                                              \
    const char* _g = (const char*)((BASE) + (size_t)(br) * K + (kt) * BK);                                          \
    __builtin_amdgcn_global_load_lds((const unsigned*)(_g + go0), (LAS unsigned*)((char*)(P) + wave_s * 1024), 16, 0, 0); \
    __builtin_amdgcn_global_load_lds((const unsigned*)(_g + go1), (LAS unsigned*)((char*)(P) + wave_s * 1024 + 8192), 16, 0, 0); \
  } while (0)
#define LDA(dst, b, h)                                                                                              \
  _Pragma("unroll") for (int m = 0; m < 4; ++m) _Pragma("unroll") for (int k = 0; k < 2; ++k)                       \
      dst[m][k] = *reinterpret_cast<const bf16x8*>((char*)SA(b, h) + lds_byte(wr * 64 + m * 16 + fr, k * 32 + fq * 8))
#define LDB(dst, b, h)                                                                                              \
  _Pragma("unroll") for (int n = 0; n < 2; ++n) _Pragma("unroll") for (int k = 0; k < 2; ++k)                       \
      dst[n][k] = *reinterpret_cast<const bf16x8*>((char*)SB(b, h) + lds_byte(wc * 32 + n * 16 + fr, k * 32 + fq * 8))
#define MMA(ai, bj, At_, Bt_)                                                                                       \
  do {                                                                                                              \
    __builtin_amdgcn_s_setprio(1);                                                                                  \
    _Pragma("unroll") for (int m = 0; m < 4; ++m) _Pragma("unroll") for (int n = 0; n < 2; ++n)                     \
        _Pragma("unroll") for (int k = 0; k < 2; ++k) acc[ai][bj][m][n] =                                           \
            __builtin_amdgcn_mfma_f32_16x16x32_bf16(At_[m][k], Bt_[n][k], acc[ai][bj][m][n], 0, 0, 0);              \
    __builtin_amdgcn_s_setprio(0);                                                                                  \
  } while (0)
#define WAIT_V(n) asm volatile("s_waitcnt vmcnt(" #n ")" ::: "memory")
#define WAIT_L(n) asm volatile("s_waitcnt lgkmcnt(" #n ")" ::: "memory")
#define BAR __builtin_amdgcn_s_barrier()
#define SCHED __builtin_amdgcn_sched_barrier(0)
  bf16x8 At[4][2], B0[2][2], B1[2][2];
  STAGE(SB(0, 0), Bt, 0, 0); STAGE(SA(0, 0), A, 0, 0);
  STAGE(SB(0, 1), Bt, HALF, 0); STAGE(SA(0, 1), A, HALF, 0);
  if (wr == 1) BAR;
  WAIT_V(4); BAR;
  STAGE(SB(1, 0), Bt, 0, 1); STAGE(SA(1, 0), A, 0, 1); STAGE(SB(1, 1), Bt, HALF, 1);
  WAIT_V(6); BAR;
#pragma unroll 1
  for (int t = 0; t < nt - 2; t += 2) {
    if (t == nt / 2) mid(acc);
    LDB(B0, 0, 0); SCHED; LDA(At, 0, 0); STAGE(SA(1, 1), A, HALF, t + 1);
    WAIT_L(8); BAR; WAIT_L(0); MMA(0, 0, At, B0); BAR; SCHED;
    LDB(B1, 0, 1); STAGE(SB(0, 0), Bt, 0, t + 2);
    BAR; WAIT_L(0); MMA(0, 1, At, B1); BAR;
    LDA(At, 0, 1); STAGE(SA(0, 0), A, 0, t + 2);
    BAR; WAIT_L(0); MMA(1, 0, At, B0); BAR; SCHED;
    STAGE(SB(0, 1), Bt, HALF, t + 2);
    WAIT_V(6); BAR; MMA(1, 1, At, B1); BAR;
    LDB(B0, 1, 0); SCHED; LDA(At, 1, 0); STAGE(SA(0, 1), A, HALF, t + 2);
    WAIT_L(8); BAR; WAIT_L(0); MMA(0, 0, At, B0); BAR; SCHED;
    LDB(B1, 1, 1); STAGE(SB(1, 0), Bt, 0, t + 3);
    BAR; WAIT_L(0); MMA(0, 1, At, B1); BAR;
    LDA(At, 1, 1); STAGE(SA(1, 0), A, 0, t + 3);
    BAR; WAIT_L(0); MMA(1, 0, At, B0); BAR; SCHED;
    STAGE(SB(1, 1), Bt, HALF, t + 3);
    WAIT_V(6); BAR; MMA(1, 1, At, B1); BAR;
  }
  {
    LDB(B0, 0, 0); LDA(At, 0, 0); STAGE(SA(1, 1), A, HALF, nt - 1);
    BAR; WAIT_L(0); MMA(0, 0, At, B0); BAR;
    LDB(B1, 0, 1); BAR; WAIT_L(0); MMA(0, 1, At, B1); BAR;
    LDA(At, 0, 1); WAIT_V(4); BAR; WAIT_L(0); MMA(1, 0, At, B0); MMA(1, 1, At, B1); BAR;
  }
  {
    LDB(B0, 1, 0); LDA(At, 1, 0); WAIT_V(2); BAR; WAIT_L(0); MMA(0, 0, At, B0); BAR;
    LDB(B1, 1, 1); WAIT_V(0); BAR; WAIT_L(0); MMA(0, 1, At, B1); BAR;
    LDA(At, 1, 1); BAR; WAIT_L(0); MMA(1, 0, At, B0); MMA(1, 1, At, B1); BAR;
  }
  if (wr == 0) BAR;
#undef SA
#undef SB
#undef STAGE
#undef LDA
#undef LDB
#undef MMA
}

constexpr int N_TPAIR = 72 + 32 + 8;
DI void weight_pair_item(const Params& p, int L, int it, unsigned char* sm, const int wave_s);
DI void sw_item(const Params& p, int L, int it, unsigned char* sm, const int wave_s);
constexpr int N_SWITEM = 16 * 5;
DI int mod_row(int m0) { return m0 < NCTX ? 0 : 1 + ((m0 - NCTX) >> 11); }


DI void phase_inproj(const Params& p, int l, unsigned char* sm, const int wave_s) {
  const ushort_t* WtIn = (const ushort_t*)(p.ws + opq_o(OFF_WTIN)) + (size_t)l * 2304 * 1024;
  const ushort_t* xg = (const ushort_t*)(p.ws + opq_o(OFF_XG));
  ushort_t* P = (ushort_t*)(p.ws + opq_o(OFF_P));
  const float* rowss = (const float*)(p.ws + opq_o(OFF_ROWSS));
  const float* swpart = (const float*)(p.ws + opq_o(OFF_SWPART));
  const float2* ropecs = (const float2*)(p.ws + opq_o(OFF_ROPE));
  {
    const int tid0 = TIDX;
    ((uint4*)(sm + L_ROPE))[tid0] = ((const uint4*)ropecs)[tid0];
  }
  for (int t = blockIdx.x; t < 9 * 48; t += gridDim.x) {
    const int pn = (t & 7) + 8 * ((t >> 3) / 9), pm = (t >> 3) % 9;
    const int brow = pm * 256, bcol = pn * 256;
    const bool lat = bcol >= NCTX;
    const int bidx = mod_row(bcol);
    f32x4 acc[2][2][4][2];
#pragma unroll
    for (int a = 0; a < 2; ++a)
#pragma unroll
      for (int b = 0; b < 2; ++b)
#pragma unroll
        for (int m = 0; m < 4; ++m)
#pragma unroll
          for (int n = 0; n < 2; ++n) acc[a][b][m][n] = (f32x4){0.f, 0.f, 0.f, 0.f};
    __syncthreads();
    {
      const int tid1 = TIDX;
      if (tid1 < 256) {
        const float* sp_ = swpart + (size_t)(l * 5 + bidx) * 2304 + brow + tid1;
        float s = 0.f;
#pragma unroll
        for (int kc = 0; kc < 16; ++kc) s += sp_[(size_t)kc * 46080];
        ((float*)(sm + L_SW))[tid1] = s;
      } else {
        const int tl = tid1 - 256;
        const float4* rs = (const float4*)(rowss + (size_t)(bcol + tl) * 8);
        const float4 s0 = rs[0], s1 = rs[1];
        const float ss = ((s0.x + s0.y) + (s0.z + s0.w)) + ((s1.x + s1.y) + (s1.z + s1.w));
        ((float*)(sm + L_RR))[tl] = rsqrtf(ss * (1.f / 1024.f) + EPS);
      }
    }
    gemm256(WtIn + (size_t)brow * 1024, xg + (size_t)bcol * 1024, acc, sm, [](f32x4(&)[2][2][4][2]) {}, wave_s);
    const int tid2 = TIDX, wid2 = tid2 >> 6, lane2 = tid2 & 63;
    const int wr = wid2 >> 2, wc = wid2 & 3, fr = lane2 & 15, fq = lane2 >> 4;
    const float* swt = (const float*)(sm + L_SW);
    const float* rrt = (const float*)(sm + L_RR);
    const float2* ropeL = (const float2*)(sm + L_ROPE);
#pragma unroll
    for (int bj = 0; bj < 2; ++bj)
#pragma unroll
      for (int n = 0; n < 2; ++n) {
        const int tloc = bj * 128 + wc * 32 + n * 16 + fr;
        const int tk = bcol + tloc;
        const float rr = rrt[tloc];
        const int tpos = (tk - NCTX) & 2047;
#pragma unroll
        for (int ai = 0; ai < 2; ++ai) {
          const int floc = ai * 128 + wr * 64;
          const int f0 = brow + floc;
          float v[4][4];
#pragma unroll
          for (int m = 0; m < 4; ++m) {
            const float4 sv = *(const float4*)(swt + floc + m * 16 + fq * 4);
            v[m][0] = acc[ai][bj][m][n][0] * rr + sv.x;
            v[m][1] = acc[ai][bj][m][n][1] * rr + sv.y;
            v[m][2] = acc[ai][bj][m][n][2] * rr + sv.z;
            v[m][3] = acc[ai][bj][m][n][3] * rr + sv.w;
          }
          if (lat && f0 < 640) {
#pragma unroll
            for (int hlf = 0; hlf < 2; ++hlf) {
              const int pos = hlf == 0 ? (tpos >> 6) : (tpos & 63);
              const float4* cp = (const float4*)(ropeL + pos * 16 + fq * 4);
              const float4 c01 = cp[0], c23 = cp[1];
              const float cs_[4] = {c01.x, c01.z, c23.x, c23.z};
              const float sn_[4] = {c01.y, c01.w, c23.y, c23.w};
#pragma unroll
              for (int e = 0; e < 4; ++e) {
                const float x1 = v[2 * hlf][e], x2 = v[2 * hlf + 1][e];
                v[2 * hlf][e] = x1 * cs_[e] - x2 * sn_[e];
                v[2 * hlf + 1][e] = x2 * cs_[e] + x1 * sn_[e];
              }
            }
          }
          const float qs = f0 < 512 ? 0.125f * LOG2E : 1.f;
#pragma unroll
          for (int m = 0; m < 4; ++m) {
            uint2 o;
            o.x = pack2(v[m][0] * qs, v[m][1] * qs);
            o.y = pack2(v[m][2] * qs, v[m][3] * qs);
            *(uint2*)(P + (size_t)tk * INW + f0 + m * 16 + fq * 4) = o;
          }
          const int f128 = f0 >> 7;
          if (!lat && (f128 == 4 || f128 == 5)) {
            const int b = tk >> 8, s = tk & 255;
            float* dst = p.out + (size_t)12582912 + (f128 == 5 ? (size_t)2097152 : 0) +
                         ((size_t)((b * 4 + l) * 256 + s)) * 128 + (f0 & 127);
#pragma unroll
            for (int m = 0; m < 4; ++m)
              *(float4*)(dst + m * 16 + fq * 4) = make_float4(v[m][0], v[m][1], v[m][2], v[m][3]);
          }
        }
      }
  }
}

DI void phase_outproj(const Params& p, int l, unsigned char* sm, const int wave_s) {
  const ushort_t* WtOut = (const ushort_t*)(p.ws + opq_o(OFF_WTOUT)) + (size_t)l * 1024 * 1024;
  const ushort_t* am = (const ushort_t*)(p.ws + opq_o(OFF_AM));
  ushort_t* xg = (ushort_t*)(p.ws + opq_o(OFF_XG));
  float* xws = (float*)(p.ws + opq_o(OFF_X));
  const float* xprev = xws;
  float* rowss = (float*)(p.ws + opq_o(OFF_ROWSS));
  const float* ssa = (const float*)(p.ws + opq_o(OFF_SSA));
  const float* ssp = (const float*)(p.ws + opq_o(OFF_SSP));
  const float* mod = (const float*)(p.ws + opq_o(OFF_MOD));
  for (int t = blockIdx.x; t < 4 * 48; t += gridDim.x) {
    const int pn = (t & 7) + 8 * ((t >> 3) >> 2), pm = (t >> 3) & 3;
    const int brow = pm * 256, bcol = pn * 256;
    const int bidx = mod_row(bcol);
    f32x4 acc[2][2][4][2];
#pragma unroll
    for (int a = 0; a < 2; ++a)
#pragma unroll
      for (int b = 0; b < 2; ++b)
#pragma unroll
        for (int m = 0; m < 4; ++m)
#pragma unroll
          for (int n = 0; n < 2; ++n) acc[a][b][m][n] = (f32x4){0.f, 0.f, 0.f, 0.f};
    __syncthreads();
    {
      const int tid1 = TIDX;
      if (tid1 < 256) {
        const int tk = bcol + tid1;
        const float4* pa = (const float4*)(ssa + (size_t)tk * 8);
        const float4* pp = (const float4*)(ssp + (size_t)tk * 8);
        const float4 a0 = pa[0], a1 = pa[1], b0 = pp[0], b1 = pp[1];
        const float sa_ = ((a0.x + a0.y) + (a0.z + a0.w)) + ((a1.x + a1.y) + (a1.z + a1.w));
        const float sp_ = ((b0.x + b0.y) + (b0.z + b0.w)) + ((b1.x + b1.y) + (b1.z + b1.w));
        const float ra = rsqrtf(sa_ * (1.f / 512.f) + EPS), rpv = rsqrtf(sp_ * (1.f / 512.f) + EPS);
        ((float*)(sm + L_RATIO))[tid1] = ra * __builtin_amdgcn_rcpf(rpv);
        ((float*)(sm + L_RP))[tid1] = rpv;
      } else {
        const int f = brow + tid1 - 256;
        const float gt = mod[(size_t)(l * 5 + bidx) * 3072 + 2048 + f];
        float gn = 0.f;
        if (l < 3) gn = p.norm_w[(size_t)(l + 1) * 1024 + f] * (1.f + mod[(size_t)((l + 1) * 5 + bidx) * 3072 + 1024 + f]);
        ((float2*)(sm + L_GG))[tid1 - 256] = make_float2(gt, gn);
      }
    }
    gemm256(WtOut + (size_t)brow * 1024, am + (size_t)bcol * 1024, acc, sm, [&](f32x4(&ac)[2][2][4][2]) {
      const int tidm = TIDX;
      const float* rt = (const float*)(sm + L_RATIO) + ((tidm >> 6) & 3) * 32 + (tidm & 15);
#pragma unroll
      for (int b = 0; b < 2; ++b)
#pragma unroll
        for (int n = 0; n < 2; ++n) {
          const float rv = rt[b * 128 + n * 16];
#pragma unroll
          for (int a = 0; a < 2; ++a)
#pragma unroll
            for (int m = 0; m < 4; ++m) ac[a][b][m][n] *= rv;
          __builtin_amdgcn_sched_barrier(0);
        }
    }, wave_s);
    const int tid2 = TIDX, wid2 = tid2 >> 6, lane2 = tid2 & 63;
    const int wr = wid2 >> 2, wc = wid2 & 3, fr = lane2 & 15, fq = lane2 >> 4;
    const int tk0 = bcol + wc * 32 + fr;
    const float* xsrc0 = (l == 0) ? (tk0 < NCTX ? p.x_prompt + (size_t)tk0 * 1024 : p.x_sample + (size_t)(tk0 - NCTX) * 1024)
                                  : xprev + (size_t)tk0 * 1024;
    const float* rpt = (const float*)(sm + L_RP) + wc * 32 + fr;
    const float rp[2][2] = {{rpt[0], rpt[16]}, {rpt[128], rpt[144]}};
    const float4* ggt = (const float4*)(sm + L_GG);
    float ssq[2][2] = {{0.f, 0.f}, {0.f, 0.f}};
#pragma unroll
    for (int ai = 0; ai < 2; ++ai) {
      float4 xv[4][2][2];
#pragma unroll
      for (int m = 0; m < 4; ++m)
#pragma unroll
        for (int bj = 0; bj < 2; ++bj)
#pragma unroll
          for (int n = 0; n < 2; ++n)
            xv[m][bj][n] = *(const float4*)(xsrc0 + (size_t)(bj * 128 + n * 16) * 1024 + brow + ai * 128 + wr * 64 + m * 16 + fq * 4);
#pragma unroll
      for (int m = 0; m < 4; ++m) {
        const int floc = ai * 128 + wr * 64 + m * 16 + fq * 4;
        const int f = brow + floc;
        const float4 g01 = ggt[(floc >> 1)], g23 = ggt[(floc >> 1) + 1];
#pragma unroll
        for (int bj = 0; bj < 2; ++bj)
#pragma unroll
          for (int n = 0; n < 2; ++n) {
            const int toff = bj * 128 + n * 16;
            const float rpv = rp[bj][n];
            const float4 x4 = xv[m][bj][n];
            float4 xn;
            xn.x = x4.x + g01.x * (acc[ai][bj][m][n][0] * rpv);
            xn.y = x4.y + g01.z * (acc[ai][bj][m][n][1] * rpv);
            xn.z = x4.z + g23.x * (acc[ai][bj][m][n][2] * rpv);
            xn.w = x4.w + g23.z * (acc[ai][bj][m][n][3] * rpv);
            ssq[bj][n] += (xn.x * xn.x + xn.y * xn.y) + (xn.z * xn.z + xn.w * xn.w);
            *(float4*)(xws + (size_t)(tk0 + toff) * 1024 + f) = xn;
            if (l < 3) {
              uint2 o;
              o.x = pack2(xn.x * g01.y, xn.y * g01.w);
              o.y = pack2(xn.z * g23.y, xn.w * g23.w);
              *(uint2*)(xg + (size_t)(tk0 + toff) * 1024 + f) = o;
            }
          }
      }
      __builtin_amdgcn_sched_barrier(0);
    }
#pragma unroll
    for (int bj = 0; bj < 2; ++bj)
#pragma unroll
      for (int n = 0; n < 2; ++n) {
        float s = ssq[bj][n];
        s += __shfl_xor(s, 16);
        s += __shfl_xor(s, 32);
        if (fq == 0) rowss[(size_t)(tk0 + bj * 128 + n * 16) * 8 + pm * 2 + wr] = s;
      }
  }
}

constexpr int AT_KS_BYTES = 320 * 144;
constexpr int AT_VT_STRIDE = 648;
DI void attn_tiles(const unsigned char* Ks, const unsigned char* Vt, int ntile, bool masked, int kbase, int qpos,
                   const bf16x8 (&qf)[4], float& m_run, float& l_run, f32x16 (&o)[2], int r, int h) {
  const int qa = qpos - r;
#pragma unroll 1
  for (int t = 0; t < ntile; ++t) {
    f32x16 s[2];
#pragma unroll
    for (int kt = 0; kt < 2; ++kt) {
#pragma unroll
      for (int i = 0; i < 16; ++i) s[kt][i] = 0.f;
      const unsigned char* kb = Ks + (t * 64 + kt * 32 + r) * 144 + h * 16;
#pragma unroll
      for (int ks = 0; ks < 4; ++ks) {
        const bf16x8 a = *(const bf16x8*)(kb + ks * 32);
        s[kt] = MFMA32(a, qf[ks], s[kt]);
      }
    }
    float mx = -3.0e38f;
    const int kb = kbase + t * 64;
    if (masked && (kb < qa - 97 || kb > qa + 65)) {
#pragma unroll
      for (int kt = 0; kt < 2; ++kt)
#pragma unroll
        for (int i = 0; i < 16; ++i) {
          const int d = qpos - (kb + kt * 32 + crow(i, h));
          float tv = s[kt][i];
          tv = (d > 128 || d < -128) ? -1.0e30f : tv;
          s[kt][i] = tv;
          mx = fmaxf(mx, tv);
        }
    } else {
#pragma unroll
      for (int kt = 0; kt < 2; ++kt)
#pragma unroll
        for (int i = 0; i < 16; ++i) mx = fmaxf(mx, s[kt][i]);
    }
    mx = fmaxf(mx, __shfl_xor(mx, 32));
    const float m_new = fmaxf(m_run, mx);
    const float alpha = __builtin_amdgcn_exp2f(m_run - m_new);
    m_run = m_new;
    f2_t ps2 = {0.f, 0.f};
    const f2_t mm2 = {m_new, m_new};
#pragma unroll
    for (int kt = 0; kt < 2; ++kt)
#pragma unroll
      for (int i = 0; i < 16; i += 2) {
        f2_t v2 = {s[kt][i], s[kt][i + 1]};
        v2 = v2 - mm2;
        f2_t e2 = {__builtin_amdgcn_exp2f(v2.x), __builtin_amdgcn_exp2f(v2.y)};
        s[kt][i] = e2.x;
        s[kt][i + 1] = e2.y;
        ps2 = ps2 + e2;
      }
    const float psum = ps2.x + ps2.y;
    l_run = l_run * alpha + psum;
#pragma unroll
    for (int i = 0; i < 16; ++i) { o[0][i] *= alpha; o[1][i] *= alpha; }
    bf16x8 pf[4];
#pragma unroll
    for (int st = 0; st < 4; ++st) {
      const int kt = st >> 1, s8 = (st & 1) * 8;
      uint4 u;
      u.x = pack2(s[kt][s8 + 0], s[kt][s8 + 1]);
      u.y = pack2(s[kt][s8 + 2], s[kt][s8 + 3]);
      u.z = pack2(s[kt][s8 + 4], s[kt][s8 + 5]);
      u.w = pack2(s[kt][s8 + 6], s[kt][s8 + 7]);
      pf[st] = __builtin_bit_cast(bf16x8, u);
    }
    const unsigned char* vb = Vt + r * AT_VT_STRIDE + (t * 64) * 2 + h * 8;
#pragma unroll
    for (int dt = 0; dt < 2; ++dt)
#pragma unroll
      for (int st = 0; st < 4; ++st) {
        const s16x4 lo = *(const s16x4*)(vb + dt * 32 * AT_VT_STRIDE + st * 32);
        const s16x4 hi = *(const s16x4*)(vb + dt * 32 * AT_VT_STRIDE + st * 32 + 16);
        const bf16x8 a = __builtin_shufflevector(lo, hi, 0, 1, 2, 3, 4, 5, 6, 7);
        o[dt] = MFMA32(a, pf[st], o[dt]);
      }
  }
}

DI void vt_store(unsigned char* Vt, int key, int ch, const uint4& vr) {
  ushort_t* vt = (ushort_t*)(Vt + (ch * 8) * AT_VT_STRIDE) + key;
  constexpr int S = AT_VT_STRIDE / 2;
  vt[0 * S] = (ushort_t)(vr.x & 0xffff);
  vt[1 * S] = (ushort_t)(vr.x >> 16);
  vt[2 * S] = (ushort_t)(vr.y & 0xffff);
  vt[3 * S] = (ushort_t)(vr.y >> 16);
  vt[4 * S] = (ushort_t)(vr.z & 0xffff);
  vt[5 * S] = (ushort_t)(vr.z >> 16);
  vt[6 * S] = (ushort_t)(vr.w & 0xffff);
  vt[7 * S] = (ushort_t)(vr.w >> 16);
}

DI void attn_item(const Params& p, int l, int item, unsigned char* sm, const int wave_s) {
  const ushort_t* P = (const ushort_t*)(p.ws + opq_o(OFF_P));
  ushort_t* am = (ushort_t*)(p.ws + opq_o(OFF_AM));
  float* ssa = (float*)(p.ws + opq_o(OFF_SSA));
  const int tid = TIDX, wave = tid >> 6, lane = tid & 63, r = lane & 31, h = lane >> 5;
  int b, kvh, q0, tokbase, klo, nkb;
  bool lat;
  if (item < 256) {
    lat = true;
    b = item >> 6;
    kvh = (item >> 5) & 1;
    q0 = (item & 31) * 64;
    tokbase = NCTX + b * 2048;
    klo = q0 - 128 < 0 ? 0 : q0 - 128;
    const int khi = q0 + 192 > 2048 ? 2048 : q0 + 192;
    nkb = khi - klo;
  } else {
    const int it = item - 256;
    lat = false;
    b = it >> 3;
    kvh = (it >> 2) & 1;
    q0 = (it & 3) * 64;
    tokbase = b * 256;
    klo = 0;
    nkb = 256;
  }
  const int hq = kvh * 4 + (wave & 3);
  const int qloc = q0 + (wave >> 2) * 32 + r;
  unsigned char* Ks = sm;
  unsigned char* Vt = sm + AT_KS_BYTES;
  {
    const int nch = nkb * 8;
    uint4 kr[5], vr[5];
#pragma unroll
    for (int i = 0; i < 5; ++i) {
      const int c = tid + i * 512;
      const int cc = c < nch ? c : nch - 1;
      const size_t tok = (size_t)(tokbase + klo + (cc >> 3));
      kr[i] = *(const uint4*)(P + tok * INW + 512 + kvh * 64 + (cc & 7) * 8);
      vr[i] = *(const uint4*)(P + tok * INW + 640 + kvh * 64 + (cc & 7) * 8);
    }
#pragma unroll
    for (int i = 0; i < 5; ++i) {
      const int c = tid + i * 512;
      if (c < nch) {
        *(uint4*)(Ks + (c >> 3) * 144 + (c & 7) * 16) = kr[i];
        vt_store(Vt, c >> 3, c & 7, vr[i]);
      }
    }
  }
  bf16x8 qf[4];
  {
    const ushort_t* qp = P + (size_t)(tokbase + qloc) * INW + hq * 64 + h * 8;
#pragma unroll
    for (int ks = 0; ks < 4; ++ks) qf[ks] = *(const bf16x8*)(qp + ks * 16);
  }
  uint2 gav[2][4];
  float4 anw[2][4];
  {
    const ushort_t* gp_ = P + (size_t)(tokbase + qloc) * INW + 768 + hq * 64 + 4 * h;
#pragma unroll
    for (int dt = 0; dt < 2; ++dt)
#pragma unroll
      for (int g = 0; g < 4; ++g) {
        gav[dt][g] = *(const uint2*)(gp_ + dt * 32 + 8 * g);
        anw[dt][g] = *(const float4*)(p.attn_norm + l * 512 + hq * 64 + dt * 32 + 8 * g + 4 * h);
      }
  }
  float m_run = p.sink[l * 8 + hq] * LOG2E;
  float l_run = (h == 0) ? 1.f : 0.f;
  f32x16 o[2];
#pragma unroll
  for (int i = 0; i < 16; ++i) { o[0][i] = 0.f; o[1][i] = 0.f; }
  uint4 ck[4], cv[4];
#pragma unroll
  for (int i = 0; i < 4; ++i) { ck[i] = make_uint4(0, 0, 0, 0); cv[i] = make_uint4(0, 0, 0, 0); }
  if (lat) {
    const size_t base = (size_t)((b * 4 + l) * 256);
#pragma unroll
    for (int i = 0; i < 4; ++i) {
      const int c = tid + i * 512;
      const int key = c >> 3, ch = c & 7;
      const float4* kp = (const float4*)(p.cache_k + (base + key) * 128 + kvh * 64 + ch * 8);
      const float4* vp = (const float4*)(p.cache_v + (base + key) * 128 + kvh * 64 + ch * 8);
      const float4 k0 = kp[0], k1 = kp[1], v0 = vp[0], v1 = vp[1];
      ck[i] = make_uint4(pack2(k0.x, k0.y), pack2(k0.z, k0.w), pack2(k1.x, k1.y), pack2(k1.z, k1.w));
      cv[i] = make_uint4(pack2(v0.x, v0.y), pack2(v0.z, v0.w), pack2(v1.x, v1.y), pack2(v1.z, v1.w));
    }
  }
  __syncthreads();
  attn_tiles(Ks, Vt, nkb >> 6, lat, klo, qloc, qf, m_run, l_run, o, r, h);
  if (lat) {
    __syncthreads();
#pragma unroll
    for (int i = 0; i < 4; ++i) {
      const int c = tid + i * 512;
      const int key = c >> 3, ch = c & 7;
      *(uint4*)(Ks + key * 144 + ch * 16) = ck[i];
      vt_store(Vt, key, ch, cv[i]);
    }
    __syncthreads();
    attn_tiles(Ks, Vt, 4, false, 0, qloc, qf, m_run, l_run, o, r, h);
  }
  const float l_tot = l_run + __shfl_xor(l_run, 32);
  const float inv = __builtin_amdgcn_rcpf(l_tot);
  const size_t m = (size_t)(tokbase + qloc);
  const float* an = p.attn_norm + l * 512 + hq * 64;
  float ssq = 0.f;
#pragma unroll
  for (int dt = 0; dt < 2; ++dt)
#pragma unroll
    for (int g = 0; g < 4; ++g) {
      const int d = dt * 32 + 8 * g + 4 * h;
      const uint2 gavv = gav[dt][g];
      const float4 w4 = anw[dt][g];
      const float o0 = o[dt][4 * g + 0] * inv, o1 = o[dt][4 * g + 1] * inv, o2 = o[dt][4 * g + 2] * inv,
                  o3 = o[dt][4 * g + 3] * inv;
      ssq += (o0 * o0 + o1 * o1) + (o2 * o2 + o3 * o3);
      uint2 ov;
      ov.x = pack2(o0 * w4.x * silu_f(bflo(gavv.x)), o1 * w4.y * silu_f(bfhi(gavv.x)));
      ov.y = pack2(o2 * w4.z * silu_f(bflo(gavv.y)), o3 * w4.w * silu_f(bfhi(gavv.y)));
      *(uint2*)(am + m * 1024 + hq * 64 + d) = ov;
    }
  ssq += __shfl_xor(ssq, 32);
  if (h == 0) ssa[m * 8 + hq] = ssq;
}

template <int HALF>
DI void pool_window(const unsigned char* U, unsigned char* Pm, int t0, int L, int tid) {
  const int cp = tid & 63, seg = tid >> 6;
  const int tl0 = seg * 16;
  const unsigned char* up = U + (tl0 + 8 - HALF) * 272 + cp * 4;
  float s0 = 0.f, s1 = 0.f;
#pragma unroll
  for (int j = 0; j < 2 * HALF; ++j) {
    const unsigned u = *(const unsigned*)(up + j * 272);
    s0 += bflo(u);
    s1 += bfhi(u);
  }
#pragma unroll
  for (int i = 0; i < 16; ++i) {
    const int tl = tl0 + i;
    const int t = t0 + tl;
    const int lo = t - HALF < 0 ? 0 : t - HALF;
    const int hi = t + HALF > L ? L : t + HALF;
    const unsigned xc = *(const unsigned*)(U + (tl + 8) * 272 + cp * 4);
    const float invc = __builtin_amdgcn_rcpf((float)(hi - lo));
    *(unsigned*)(Pm + tl * 272 + cp * 4) = pack2(s0 * invc - bflo(xc), s1 * invc - bfhi(xc));
    if (i < 15) {
      const unsigned ua = *(const unsigned*)(up + (i + 2 * HALF) * 272);
      const unsigned ub = *(const unsigned*)(up + i * 272);
      s0 += bflo(ua) - bflo(ub);
      s1 += bfhi(ua) - bfhi(ub);
    }
  }
}

DI void pool_item(const Params& p, int l, int item, unsigned char* sm, const int wave_s) {
  const ushort_t* P = (const ushort_t*)(p.ws + opq_o(OFF_P));
  ushort_t* am = (ushort_t*)(p.ws + opq_o(OFF_AM));
  float* ssp = (float*)(p.ws + opq_o(OFF_SSP));
  const ushort_t* Wp = (const ushort_t*)(p.ws + opq_o(OFF_WTPOOL));
  const int tid = TIDX, wave = tid >> 6, lane = tid & 63, r = lane & 31, h = lane >> 5;
  const int tt = item >> 2, g = item & 3;
  const int m0 = tt * 128;
  int L, sbase;
  if (m0 < NCTX) { L = 256; sbase = m0 & ~255; } else { L = 2048; sbase = NCTX + ((m0 - NCTX) & ~2047); }
  const int t0 = m0 - sbase;
  unsigned char* U = sm;
  unsigned char* W = sm + 39168;
  unsigned char* Pm = sm + 39168 + 34816;
  const ushort_t* wsrc = Wp + (size_t)(l * 4 + g) * 128 * 128;
  {
    uint4 uu[5], ww[4];
#pragma unroll
    for (int i = 0; i < 5; ++i) {
      const int c = tid + i * 512;
      const int row = c >> 4, ch = c & 15;
      const int pos = t0 - 8 + row;
      uu[i] = make_uint4(0, 0, 0, 0);
      if (c < 144 * 16 && pos >= 0 && pos < L) uu[i] = *(const uint4*)(P + (size_t)(sbase + pos) * INW + 1280 + g * 128 + ch * 8);
    }
#pragma unroll
    for (int i = 0; i < 4; ++i) {
      const int c = tid + i * 512;
      ww[i] = *(const uint4*)(wsrc + (c >> 4) * 128 + (c & 15) * 8);
    }
#pragma unroll
    for (int i = 0; i < 5; ++i) {
      const int c = tid + i * 512;
      if (c < 144 * 16) *(uint4*)(U + (c >> 4) * 272 + (c & 15) * 16) = uu[i];
    }
#pragma unroll
    for (int i = 0; i < 4; ++i) {
      const int c = tid + i * 512;
      *(uint4*)(W + (c >> 4) * 272 + (c & 15) * 16) = ww[i];
    }
  }
  const int wm = wave & 3, wn = wave >> 2;
  const size_t m = (size_t)(m0 + wm * 32 + r);
  uint2 gpv_[2][4];
  float4 ps_[2][4], pn_[2][4];
#pragma unroll
  for (int nt = 0; nt < 2; ++nt)
#pragma unroll
    for (int gq = 0; gq < 4; ++gq)
    {
      const int c_ = g * 128 + wn * 64 + nt * 32 + 8 * gq + 4 * h;
      gpv_[nt][gq] = *(const uint2*)(P + m * INW + 1792 + c_);
      ps_[nt][gq] = *(const float4*)(p.pool_scale + l * 512 + c_);
      pn_[nt][gq] = *(const float4*)(p.pool_norm + l * 512 + c_);
    }
  __syncthreads();
  switch (g) {
    case 0: pool_window<1>(U, Pm, t0, L, tid); break;
    case 1: pool_window<2>(U, Pm, t0, L, tid); break;
    case 2: pool_window<4>(U, Pm, t0, L, tid); break;
    default: pool_window<8>(U, Pm, t0, L, tid); break;
  }
  __syncthreads();
  f32x16 acc[2];
#pragma unroll
  for (int i = 0; i < 16; ++i) { acc[0][i] = 0.f; acc[1][i] = 0.f; }
  const unsigned char* wa = W + (wn * 64 + r) * 272 + h * 16;
  const unsigned char* pb = Pm + (wm * 32 + r) * 272 + h * 16;
#pragma unroll
  for (int ks = 0; ks < 8; ++ks) {
    const bf16x8 bq = *(const bf16x8*)(pb + ks * 32);
    const bf16x8 a0 = *(const bf16x8*)(wa + ks * 32);
    const bf16x8 a1 = *(const bf16x8*)(wa + 32 * 272 + ks * 32);
    acc[0] = MFMA32(a0, bq, acc[0]);
    acc[1] = MFMA32(a1, bq, acc[1]);
  }
  float ssq = 0.f;
#pragma unroll
  for (int nt = 0; nt < 2; ++nt)
#pragma unroll
    for (int gq = 0; gq < 4; ++gq) {
      const int c = g * 128 + wn * 64 + nt * 32 + 8 * gq + 4 * h;
      const float4 ps = ps_[nt][gq];
      const float4 pn = pn_[nt][gq];
      const uint2 gpv = gpv_[nt][gq];
      const float o0 = acc[nt][4 * gq + 0] * ps.x, o1 = acc[nt][4 * gq + 1] * ps.y, o2 = acc[nt][4 * gq + 2] * ps.z,
                  o3 = acc[nt][4 * gq + 3] * ps.w;
      ssq += (o0 * o0 + o1 * o1) + (o2 * o2 + o3 * o3);
      uint2 ov;
      ov.x = pack2(o0 * pn.x * silu_f(bflo(gpv.x)), o1 * pn.y * silu_f(bfhi(gpv.x)));
      ov.y = pack2(o2 * pn.z * silu_f(bflo(gpv.y)), o3 * pn.w * silu_f(bfhi(gpv.y)));
      *(uint2*)(am + m * 1024 + 512 + c) = ov;
    }
  ssq += __shfl_xor(ssq, 32);
  if (h == 0) ssp[m * 8 + g * 2 + wn] = ssq;
}

DI void transpose_item(const float* __restrict__ src, ushort_t* __restrict__ dst, int R, int C, int r0, int c0,
                       unsigned char* sm, int t256) {
  float* T = (float*)sm;
  const int rr = t256 >> 4, cc4 = (t256 & 15) * 4;
#pragma unroll
  for (int i = 0; i < 4; ++i) {
    const int row = rr + 16 * i;
    const float4 v = *(const float4*)(src + (size_t)(r0 + row) * C + c0 + cc4);
    T[row * 65 + cc4 + 0] = v.x;
    T[row * 65 + cc4 + 1] = v.y;
    T[row * 65 + cc4 + 2] = v.z;
    T[row * 65 + cc4 + 3] = v.w;
  }
  __syncthreads();
  const int c = t256 >> 2, rseg = (t256 & 3) * 16;
  uint4 o0, o1;
  o0.x = pack2(T[(rseg + 0) * 65 + c], T[(rseg + 1) * 65 + c]);
  o0.y = pack2(T[(rseg + 2) * 65 + c], T[(rseg + 3) * 65 + c]);
  o0.z = pack2(T[(rseg + 4) * 65 + c], T[(rseg + 5) * 65 + c]);
  o0.w = pack2(T[(rseg + 6) * 65 + c], T[(rseg + 7) * 65 + c]);
  o1.x = pack2(T[(rseg + 8) * 65 + c], T[(rseg + 9) * 65 + c]);
  o1.y = pack2(T[(rseg + 10) * 65 + c], T[(rseg + 11) * 65 + c]);
  o1.z = pack2(T[(rseg + 12) * 65 + c], T[(rseg + 13) * 65 + c]);
  o1.w = pack2(T[(rseg + 14) * 65 + c], T[(rseg + 15) * 65 + c]);
  ushort_t* d = dst + (size_t)(c0 + c) * R + r0 + rseg;
  *(uint4*)d = o0;
  *(uint4*)(d + 8) = o1;
}


template <bool NT>
DI void transpose_strip(const float* __restrict__ src, ushort_t* __restrict__ dst, int R, int C, int r0, int c0,
                        unsigned char* sm, int t256) {
  float* T = (float*)sm;
  const int rr = t256 >> 6, cc4 = (t256 & 63) * 4;
  float4 v[16];
#pragma unroll
  for (int i = 0; i < 16; ++i) {
    const float* q = src + (size_t)(r0 + rr + 4 * i) * C + c0 + cc4;
    if constexpr (NT) {
      const f32x4 t4 = __builtin_nontemporal_load((const f32x4*)q);
      v[i] = make_float4(t4[0], t4[1], t4[2], t4[3]);
    } else {
      v[i] = *(const float4*)q;
    }
  }
#pragma unroll
  for (int i = 0; i < 16; ++i) {
    float* t = T + (rr + 4 * i) * 257 + cc4;
    t[0] = v[i].x; t[1] = v[i].y; t[2] = v[i].z; t[3] = v[i].w;
  }
  __syncthreads();
  ushort_t* d = dst + (size_t)(c0 + t256) * R + r0;
#pragma unroll
  for (int g = 0; g < 8; ++g) {
    uint4 o;
    o.x = pack2(T[(8 * g + 0) * 257 + t256], T[(8 * g + 1) * 257 + t256]);
    o.y = pack2(T[(8 * g + 2) * 257 + t256], T[(8 * g + 3) * 257 + t256]);
    o.z = pack2(T[(8 * g + 4) * 257 + t256], T[(8 * g + 5) * 257 + t256]);
    o.w = pack2(T[(8 * g + 6) * 257 + t256], T[(8 * g + 7) * 257 + t256]);
    *(uint4*)(d + 8 * g) = o;
  }
}

DI void weight_pair_item(const Params& p, int L, int it, unsigned char* sm, const int wave_s) {
  const int tid = TIDX;
  const int half = tid >> 8, t256 = tid & 255;
  if (it < 72) {
    const int it2 = it * 2 + half;
    const int rt = it2 / 9, ct = it2 % 9;
    transpose_strip<false>(p.w_in + (size_t)L * 1024 * 2304, (ushort_t*)(p.ws + OFF_WTIN) + (size_t)L * 2304 * 1024, 1024, 2304,
                    rt * 64, ct * 256, sm + half * 65792, t256);
  } else if (it < 72 + 32) {
    const int it2 = (it - 72) * 2 + half;
    const int rt = it2 >> 2, ct = it2 & 3;
    transpose_strip<true>(p.w_out + (size_t)L * 1024 * 1024, (ushort_t*)(p.ws + OFF_WTOUT) + (size_t)L * 1024 * 1024, 1024, 1024,
                    rt * 64, ct * 256, sm + half * 65792, t256);
  } else {
    const int it2 = (it - 72 - 32) * 2 + half;
    const int mat = L * 4 + (it2 >> 2), rt = (it2 >> 1) & 1, ct = it2 & 1;
    transpose_item(p.w_pool + (size_t)mat * 128 * 128, (ushort_t*)(p.ws + OFF_WTPOOL) + (size_t)mat * 128 * 128, 128, 128,
                   rt * 64, ct * 64, sm + half * 16640, t256);
  }
}

DI void mod_item(const Params& p, int L, int cg64, unsigned char* sm, const int wave_s) {
  const int tid = TIDX, wave = tid >> 6, lane = tid & 63;
  float* sv = (float*)sm;
  float* red = (float*)(sm + 20480);
  for (int idx = tid; idx < 5120; idx += 512) {
    const int rr = idx >> 10, k = idx & 1023;
    const float cv = rr == 0 ? p.c_ctx[k] : p.c[(rr - 1) * 1024 + k];
    sv[idx] = silu_f(cv);
  }
  __syncthreads();
  const int j = cg64 * 64 + lane;
  const float* wp = p.w_ada + ((size_t)L * 1024 + wave * 128) * 3072 + j;
  const float* s0 = sv + wave * 128;
  float a0 = 0.f, a1 = 0.f, a2 = 0.f, a3 = 0.f, a4 = 0.f;
#pragma unroll 8
  for (int kk = 0; kk < 128; ++kk) {
    const float w = __builtin_nontemporal_load(wp + (size_t)kk * 3072);
    a0 += s0[kk] * w;
    a1 += s0[1024 + kk] * w;
    a2 += s0[2048 + kk] * w;
    a3 += s0[3072 + kk] * w;
    a4 += s0[4096 + kk] * w;
  }
  float* rd = red + (wave * 5) * 64 + lane;
  rd[0] = a0; rd[64] = a1; rd[128] = a2; rd[192] = a3; rd[256] = a4;
  __syncthreads();
  if (tid < 320) {
    const int rr = tid >> 6, c = tid & 63;
    float s = p.b_ada[L * 3072 + cg64 * 64 + c];
#pragma unroll
    for (int w = 0; w < 8; ++w) s += red[(w * 5 + rr) * 64 + c];
    ((float*)(p.ws + OFF_MOD))[(size_t)(L * 5 + rr) * 3072 + cg64 * 64 + c] = s;
  }
}

DI void sw_item(const Params& p, int L, int it, unsigned char* sm, const int wave_s) {
  const int tid = TIDX, half = tid >> 8, t256 = tid & 255;
  const int kc = it / 5, cgp = (it % 5) * 2 + half;
  const float* mod = (const float*)(p.ws + OFF_MOD);
  float* sh = (float*)sm + half * 320;
  for (int idx = t256; idx < 320; idx += 256) {
    const int rr = idx >> 6, kk = idx & 63;
    sh[idx] = mod[(size_t)(L * 5 + rr) * 3072 + kc * 64 + kk];
  }
  __syncthreads();
  if (cgp < 9) {
    const int n = cgp * 256 + t256;
    float a0 = 0.f, a1 = 0.f, a2 = 0.f, a3 = 0.f, a4 = 0.f;
    const float* wp = p.w_in + ((size_t)L * 1024 + kc * 64) * 2304 + n;
#pragma unroll 8
    for (int kk = 0; kk < 64; ++kk) {
      const float w = __builtin_nontemporal_load(wp + (size_t)kk * 2304);
      a0 += sh[kk] * w;
      a1 += sh[64 + kk] * w;
      a2 += sh[128 + kk] * w;
      a3 += sh[192 + kk] * w;
      a4 += sh[256 + kk] * w;
    }
    float* sp = (float*)(p.ws + OFF_SWPART) + ((size_t)(kc * 4 + L) * 5) * 2304 + n;
    sp[0] = a0; sp[2304] = a1; sp[2 * 2304] = a2; sp[3 * 2304] = a3; sp[4 * 2304] = a4;
  }
}

DI void sincos_d(double a, double& sn, double& cs) {
  const double twopi = 6.283185307179586476925;
  const double n = rint(a / twopi);
  const double x = a - n * twopi;
  const double x2 = x * x;
  double ts = x, tc = 1.0, s = x, c = 1.0;
#pragma unroll 1
  for (int k = 1; k <= 16; ++k) {
    tc = -tc * x2 / (double)((2 * k - 1) * (2 * k));
    ts = -ts * x2 / (double)((2 * k) * (2 * k + 1));
    c += tc;
    s += ts;
  }
  sn = s;
  cs = c;
}

__global__ void __launch_bounds__(512, 2) fwd_megakernel(Params p) {
  cg::grid_group grid = cg::this_grid();
  __shared__ __attribute__((aligned(16))) unsigned char sm[SMEM_TOTAL];
  uint4& xb_words = *(uint4*)(sm + L_XB);
  const int nblk = gridDim.x;
  const int wave_s = __builtin_amdgcn_readfirstlane((int)(threadIdx.x >> 6));
  if (p.ws == nullptr) grid.sync();
  const bool is_t0 = (TIDX == 0);
  if (is_t0) xb_words = make_uint4(0u, 0u, 0u, 0u);
  __syncthreads();
  (void)xcd_barrier_post((unsigned*)(p.ws + OFF_BAR), (volatile LAS unsigned*)&xb_words, is_t0);
#define GRID_SYNC()                                            \
  do {                                                         \
    XcdBarrier xb_;                                            \
    xb_.bar = (unsigned*)(p.ws + opq_o(OFF_BAR));              \
    xb_.x = xb_xcc_id();                                       \
    xb_.st = (volatile LAS unsigned*)&xb_words;                \
    xcd_barrier(xb_, TIDX == 0);                               \
  } while (0)

  {
    const int tid = TIDX;
    constexpr int TOTAL = 4 * N_TPAIR + 4 * 48 + 1;
    for (int item = blockIdx.x; item < TOTAL; item += nblk) {
      __syncthreads();
      if (item < 4 * N_TPAIR) {
        weight_pair_item(p, item / N_TPAIR, item % N_TPAIR, sm, wave_s);
      } else if (item < 4 * N_TPAIR + 192) {
        mod_item(p, (item - 4 * N_TPAIR) / 48, (item - 4 * N_TPAIR) % 48, sm, wave_s);
      } else {
        float2* rc = (float2*)(p.ws + OFF_ROPE);
        for (int idx = tid; idx < 1024; idx += 512) {
          const int pos = idx >> 4, fi = idx & 15;
          const float inv = __builtin_amdgcn_exp2f(-(float)fi * (1.f / 16.f) * 13.287712379549449f);
          const float ang = (float)pos * inv;
          double sn, cs;
          sincos_d((double)ang, sn, cs);
          rc[idx] = make_float2((float)cs, (float)sn);
        }
      }
    }
  }
  GRID_SYNC();
  {
    for (int item = blockIdx.x; item < 4 * N_SWITEM; item += nblk) {
      __syncthreads();
      sw_item(p, item / N_SWITEM, item % N_SWITEM, sm, wave_s);
    }
    const float* mod = (const float*)(p.ws + OFF_MOD);
    ushort_t* xg = (ushort_t*)(p.ws + OFF_XG);
    float* rowss = (float*)(p.ws + OFF_ROWSS);
    const int tidr = TIDX, lane = tidr & 63;
    const int rstride = nblk * 8;
    for (int row0 = blockIdx.x * 8 + (tidr >> 6); row0 < NTOK; row0 += 6 * rstride) {
      float4 v[6][4];
      bool ok[6];
#pragma unroll
      for (int u = 0; u < 6; ++u) {
        const int row = row0 + u * rstride;
        ok[u] = row < NTOK;
        const int rw = ok[u] ? row : row0;
        const float* src = rw < NCTX ? p.x_prompt + (size_t)rw * 1024 : p.x_sample + (size_t)(rw - NCTX) * 1024;
#pragma unroll
        for (int i = 0; i < 4; ++i) v[u][i] = *(const float4*)(src + lane * 4 + 256 * i);
      }
#pragma unroll
      for (int u = 0; u < 6; ++u) {
        const int row = row0 + u * rstride;
        if (!ok[u]) continue;
        const float* scl = mod + (size_t)mod_row(row) * 3072 + 1024;
        float ss = 0.f;
#pragma unroll
        for (int i = 0; i < 4; ++i) {
          const int n = lane * 4 + 256 * i;
          const float4 x4 = v[u][i];
          const float4 sc = *(const float4*)(scl + n);
          const float4 w4 = *(const float4*)(p.norm_w + n);
          ss += (x4.x * x4.x + x4.y * x4.y) + (x4.z * x4.z + x4.w * x4.w);
          uint2 o;
          o.x = pack2(x4.x * (w4.x * (1.f + sc.x)), x4.y * (w4.y * (1.f + sc.y)));
          o.y = pack2(x4.z * (w4.z * (1.f + sc.z)), x4.w * (w4.w * (1.f + sc.w)));
          *(uint2*)(xg + (size_t)row * 1024 + n) = o;
        }
#pragma unroll
        for (int off = 32; off >= 1; off >>= 1) ss += __shfl_xor(ss, off);
        if (lane < 8) rowss[(size_t)row * 8 + lane] = lane == 0 ? ss : 0.f;
      }
    }
  }
  GRID_SYNC();
#pragma unroll 1
  for (int l = 0; l < 4; ++l) {
    phase_inproj(p, l, sm, wave_s);
    GRID_SYNC();
    if (nblk == 256) {
      const int xq = blockIdx.x & 7, rq = blockIdx.x >> 3;
      __syncthreads();
      attn_item(p, l, (rq >> 3) * 64 + ((rq >> 2) & 1) * 32 + 4 * xq + (rq & 3), sm, wave_s);
      __syncthreads();
      if (rq < 16) {
        attn_item(p, l, 256 + (xq + 8 * (rq >> 3)) * 8 + ((rq >> 2) & 1) * 4 + (rq & 3), sm, wave_s);
      } else {
        const int e = rq - 16;
        pool_item(p, l, (2 * (xq + 8 * (e >> 3)) + ((e >> 2) & 1)) * 4 + (e & 3), sm, wave_s);
      }
      __syncthreads();
      {
        const int e = 16 + rq;
        pool_item(p, l, (2 * (xq + 8 * (e >> 3)) + ((e >> 2) & 1)) * 4 + (e & 3), sm, wave_s);
      }
    } else {
      for (int item = blockIdx.x; item < 384 + 384; item += nblk) {
        __syncthreads();
        if (item < 384) attn_item(p, l, item, sm, wave_s);
        else pool_item(p, l, item - 384, sm, wave_s);
      }
    }
    GRID_SYNC();
    phase_outproj(p, l, sm, wave_s);
    GRID_SYNC();
  }
  {
    const float* xws = (const float*)(p.ws + OFF_X);
    const float* rowss = (const float*)(p.ws + OFF_ROWSS);
    const int tidr = TIDX, lane = tidr & 63;
    const int rstride = nblk * 8;
    for (int row0 = blockIdx.x * 8 + (tidr >> 6); row0 < NTOK; row0 += 6 * rstride) {
      float4 v[6][4];
      float rr[6];
#pragma unroll
      for (int u = 0; u < 6; ++u) {
        const int row = (row0 + u * rstride) < NTOK ? (row0 + u * rstride) : row0;
        const float4* rs = (const float4*)(rowss + (size_t)row * 8);
        const float4 s0 = rs[0], s1 = rs[1];
        rr[u] = rsqrtf((((s0.x + s0.y) + (s0.z + s0.w)) + ((s1.x + s1.y) + (s1.z + s1.w))) * (1.f / 1024.f) + EPS);
#pragma unroll
        for (int i = 0; i < 4; ++i) v[u][i] = *(const float4*)(xws + (size_t)row * 1024 + lane * 4 + 256 * i);
      }
#pragma unroll
      for (int u = 0; u < 6; ++u) {
        const int row = row0 + u * rstride;
        if (row >= NTOK) continue;
#pragma unroll
        for (int i = 0; i < 4; ++i) {
          const int n = lane * 4 + 256 * i;
          const float4 w4 = *(const float4*)(p.final_norm + n);
          const float4 x4 = v[u][i];
          *(float4*)(p.out + (size_t)row * 1024 + n) =
              make_float4(x4.x * rr[u] * w4.x, x4.y * rr[u] * w4.y, x4.z * rr[u] * w4.z, x4.w * rr[u] * w4.w);
        }
      }
    }
  }
}

extern "C" void kernel_launch(void* const* d_in, const int* in_sizes, int n_in, void* d_out, int out_size, void* d_ws,
                              size_t ws_size, hipStream_t stream) {
  static int grid_blocks = 0;
  if (!grid_blocks) {
    int dev = 0, cus = 0, per_cu = 0;
    (void)hipGetDevice(&dev);
    (void)hipDeviceGetAttribute(&cus, hipDeviceAttributeMultiprocessorCount, dev);
    (void)hipOccupancyMaxActiveBlocksPerMultiprocessor(&per_cu, fwd_megakernel, 512, 0);
    if (per_cu < 1) fprintf(stderr, "occupancy query reports %d blocks per CU\n", per_cu);
    grid_blocks = cus;
  }
  Params p{};
  p.x_prompt = (const float*)d_in[0];
  p.x_sample = (const float*)d_in[1];
  p.cache_k = (const float*)d_in[2];
  p.cache_v = (const float*)d_in[3];
  p.c = (const float*)d_in[4];
  p.c_ctx = (const float*)d_in[5];
  p.norm_w = (const float*)d_in[6];
  p.w_ada = (const float*)d_in[7];
  p.b_ada = (const float*)d_in[8];
  p.w_in = (const float*)d_in[9];
  p.sink = (const float*)d_in[10];
  p.attn_norm = (const float*)d_in[11];
  p.pool_norm = (const float*)d_in[12];
  p.w_pool = (const float*)d_in[13];
  p.pool_scale = (const float*)d_in[14];
  p.w_out = (const float*)d_in[15];
  p.final_norm = (const float*)d_in[16];
  p.out = (float*)d_out;
  p.ws = (unsigned char*)d_ws;
  (void)hipMemsetAsync((unsigned char*)d_ws + OFF_BAR, 0, XCD_BAR_WORDS * 4, stream);
  void* args[] = {&p};
  hipError_t e = hipLaunchCooperativeKernel((void*)fwd_megakernel, dim3(grid_blocks), dim3(512), args, 0, stream);
  if (e != hipSuccess) fprintf(stderr, "cooperative launch failed: %s (grid %d)\n", hipGetErrorString(e), grid_blocks);
}
```
